# Optimizing an MI355X kernel written in HIP

```python
import math
import jax, jax.numpy as jnp
from jax import lax
import numpy as np


D_MODEL = 1024
BATCH = 8
SEQ = 2048
DEPTH = 2

N_A_LAYERS = DEPTH // 2
N_B_LAYERS = DEPTH - N_A_LAYERS

A_CHUNK = 128
A_GROUPS = 8
A_WIDTH = 2 * D_MODEL
A_GROUP_DIM = A_WIDTH // A_GROUPS

B_HEADS = 16
B_HEAD_DIM = D_MODEL // B_HEADS
B_BLOCK = 256
B_TOPK = 3
B_QCHUNK = 32

N_EXPERTS = 64
TOP_K = 8
N_GROUPS = 8
TOPK_GROUPS = 4
EXPERT_DIM = 256
SHARED_DIM = 256
ROUTED_SCALE = 2.5
MOE_ROW_BLOCK = 128

RMS_EPS = 1e-6
LN_EPS = 1e-5
NEG_INF = -1e30

kernel_name = 'hybrid_gmlp_moba_moe_yoco'


def rmsnorm(x, g):
    xf = x.astype(jnp.float32)
    y = xf * lax.rsqrt(jnp.mean(xf * xf, axis=-1, keepdims=True) + RMS_EPS)
    return y.astype(x.dtype) * g


def layernorm(x, g, b):
    xf = x.astype(jnp.float32)
    mu = jnp.mean(xf, axis=-1, keepdims=True)
    var = jnp.mean(jnp.square(xf - mu), axis=-1, keepdims=True)
    y = (xf - mu) * lax.rsqrt(var + LN_EPS)
    return y.astype(x.dtype) * g + b


def ada(c, w, b, n):
    m = jax.nn.silu(c) @ w + b
    return [t[:, None, :] for t in jnp.split(m, n, axis=-1)]


def modulate(h, shift, scale):
    return h * (1 + scale) + shift


def swiglu(x, wg, wu, wd):
    return (jax.nn.silu(x @ wg) * (x @ wu)) @ wd


def gmlp_mixer(h, w_in, b_in, ln_g, ln_b, w_s, b_s, w_out):
    B, S, _ = h.shape
    z = jax.nn.gelu(h @ w_in + b_in)
    u, v = jnp.split(z, 2, axis=-1)
    v = layernorm(v, ln_g, ln_b)
    nc = S // A_CHUNK
    v = v.reshape(B, nc, A_CHUNK, A_GROUPS, A_GROUP_DIM)
    causal = jnp.tril(jnp.ones((A_CHUNK, A_CHUNK), dtype=bool))
    w = jnp.where(causal[None], w_s, 0)
    sv = jnp.einsum('gts,bcsgd->bctgd', w, v) + b_s.T[None, None, :, :, None]
    y = u * sv.reshape(B, S, A_WIDTH)
    return y @ w_out


def shared_kv(x, c, g, w_ada, b_ada, w_k, w_v):
    shift, scale = ada(c, w_ada, b_ada, 2)
    h = modulate(rmsnorm(x, g), shift, scale)
    B, S, _ = h.shape
    k = (h @ w_k).reshape(B, S, B_HEADS, B_HEAD_DIM).transpose(0, 2, 1, 3)
    v = (h @ w_v).reshape(B, S, B_HEADS, B_HEAD_DIM).transpose(0, 2, 1, 3)
    nb = -(-S // B_BLOCK)
    pad = nb * B_BLOCK - S
    k = jnp.pad(k, ((0, 0), (0, 0), (0, pad), (0, 0)))
    v = jnp.pad(v, ((0, 0), (0, 0), (0, pad), (0, 0)))
    kb = k.reshape(B, B_HEADS, nb, B_BLOCK, B_HEAD_DIM)
    vb = v.reshape(B, B_HEADS, nb, B_BLOCK, B_HEAD_DIM)
    kmean = jnp.mean(kb, axis=3)
    return kb, vb, kmean


def moba_attention(q, kb, vb, kmean):
    B, H, S, dh = q.shape
    nb = kb.shape[2]
    n_sel = min(B_TOPK, nb - 1)
    scale = dh ** -0.5
    nqc = S // B_QCHUNK
    qc = q.reshape(B, H, nqc, B_QCHUNK, dh).transpose(0, 2, 1, 3, 4)
    head_idx = jnp.arange(H)[:, None, None]

    def one_seq(args):
        q_s, kb_s, vb_s, km_s = args

        def one_chunk(args2):
            ci, q_c = args2
            start = ci * B_QCHUNK
            own = start // B_BLOCK
            qpos = start + jnp.arange(B_QCHUNK)
            kpos = own * B_BLOCK + jnp.arange(B_BLOCK)
            k_own = lax.dynamic_index_in_dim(kb_s, own, axis=1, keepdims=False)
            v_own = lax.dynamic_index_in_dim(vb_s, own, axis=1, keepdims=False)
            s_own = jnp.einsum('hqd,hjd->hqj', q_c, k_own).astype(jnp.float32) * scale
            s_own = jnp.where((kpos[None, :] <= qpos[:, None])[None], s_own, NEG_INF)
            if n_sel > 0:
                gate = jnp.einsum('hqd,hnd->hqn', q_c, km_s).astype(jnp.float32)
                past = jnp.arange(nb) < own
                gate = jnp.where(past[None, None, :], gate, NEG_INF)
                _, idx = lax.top_k(gate, n_sel)
                valid = idx < own
                k_sel = kb_s[head_idx, idx]
                v_sel = vb_s[head_idx, idx]
                s_sel = jnp.einsum('hqd,hqnjd->hqnj', q_c, k_sel).astype(jnp.float32) * scale
                s_sel = jnp.where(valid[..., None], s_sel, NEG_INF)
                s = jnp.concatenate([s_sel.reshape(H, B_QCHUNK, n_sel * B_BLOCK), s_own], axis=-1)
                p = jax.nn.softmax(s, axis=-1).astype(v_own.dtype)
                p_sel = p[..., :n_sel * B_BLOCK].reshape(H, B_QCHUNK, n_sel, B_BLOCK)
                p_own = p[..., n_sel * B_BLOCK:]
                o = (jnp.einsum('hqnj,hqnjd->hqd', p_sel, v_sel)
                     + jnp.einsum('hqj,hjd->hqd', p_own, v_own))
            else:
                p = jax.nn.softmax(s_own, axis=-1).astype(v_own.dtype)
                o = jnp.einsum('hqj,hjd->hqd', p, v_own)
            return o

        return lax.map(one_chunk, (jnp.arange(nqc), q_s))

    o = lax.map(one_seq, (qc, kb, vb, kmean))
    return o.transpose(0, 2, 1, 3, 4).reshape(B, H, S, dh)


def moba_mixer(h, w_q, w_o, kb, vb, kmean):
    B, S, D = h.shape
    q = (h @ w_q).reshape(B, S, B_HEADS, B_HEAD_DIM).transpose(0, 2, 1, 3)
    o = moba_attention(q, kb, vb, kmean)
    return o.transpose(0, 2, 1, 3).reshape(B, S, D) @ w_o


def grouped_experts(xt, eidx, w, w_gate, w_up, w_down):
    T, D = xt.shape
    K = eidx.shape[1]
    E, M = N_EXPERTS, MOE_ROW_BLOCK
    TK = T * K
    e_flat = eidx.reshape(TK)
    tok_flat = jnp.arange(TK, dtype=jnp.int32) // K
    w_flat = w.reshape(TK)
    order = jnp.argsort(e_flat)
    e_sorted = e_flat[order]
    tok_sorted = tok_flat[order]
    w_sorted = w_flat[order]
    counts = jnp.zeros((E,), jnp.int32).at[e_flat].add(1)
    starts = jnp.cumsum(counts) - counts
    padded = ((counts + M - 1) // M) * M
    pad_ends = jnp.cumsum(padded)
    pad_starts = pad_ends - padded
    rank = jnp.arange(TK, dtype=jnp.int32) - starts[e_sorted]
    dest = pad_starts[e_sorted] + rank
    n_blocks = -(-(TK + E * (M - 1)) // M)
    R = n_blocks * M
    x_pad = jnp.zeros((R, D), xt.dtype).at[dest].set(xt[tok_sorted])
    block_start = jnp.arange(n_blocks, dtype=jnp.int32) * M
    block_expert = jnp.minimum(jnp.sum(pad_ends[None, :] <= block_start[:, None], axis=1), E - 1)

    def run_block(args):
        xb, e = args
        return swiglu(xb, w_gate[e], w_up[e], w_down[e])

    y_pad = lax.map(run_block, (x_pad.reshape(n_blocks, M, D), block_expert)).reshape(R, D)
    y = y_pad[dest] * w_sorted[:, None].astype(xt.dtype)
    return jax.ops.segment_sum(y, tok_sorted, num_segments=T)


def moe(h, w_router, e_bias, w_gate, w_up, w_down, ws_gate, ws_up, ws_down):
    B, S, D = h.shape
    T = B * S
    xt = h.reshape(T, D)
    scores = jax.nn.sigmoid((xt @ w_router).astype(jnp.float32))
    choice = scores + e_bias.astype(jnp.float32)
    grp = choice.reshape(T, N_GROUPS, N_EXPERTS // N_GROUPS)
    grp_score = jnp.sum(lax.top_k(grp, 2)[0], axis=-1)
    _, gidx = lax.top_k(grp_score, TOPK_GROUPS)
    gmask = jnp.sum(jax.nn.one_hot(gidx, N_GROUPS, dtype=jnp.float32), axis=1) > 0
    emask = jnp.repeat(gmask, N_EXPERTS // N_GROUPS, axis=1)
    choice = jnp.where(emask, choice, NEG_INF)
    _, eidx = lax.top_k(choice, TOP_K)
    w = jnp.take_along_axis(scores, eidx, axis=1)
    w = w / jnp.sum(w, axis=-1, keepdims=True) * ROUTED_SCALE
    routed = grouped_experts(xt, eidx, w, w_gate, w_up, w_down)
    shared = swiglu(xt, ws_gate, ws_up, ws_down)
    return (routed + shared).reshape(B, S, D)


def setup_inputs(seed: int = 0) -> dict:
    key = jax.random.key(seed)
    ks = jax.random.split(key, 32)
    f32 = jnp.float32

    def nrm(k, shape, s):
        return jax.random.normal(k, shape, f32) * s

    D = D_MODEL
    return {
        'x': nrm(ks[0], (BATCH, SEQ, D), 1.0),
        'c': nrm(ks[1], (BATCH, D), 1.0),
        'ada_w': nrm(ks[2], (DEPTH, D, 6 * D), 0.2 * D ** -0.5),
        'ada_b': nrm(ks[3], (DEPTH, 6 * D), 0.02),
        'norm_mix': 1.0 + nrm(ks[4], (DEPTH, D), 0.02),
        'norm_ffn': 1.0 + nrm(ks[5], (DEPTH, D), 0.02),
        'a_w_in': nrm(ks[6], (N_A_LAYERS, D, 2 * A_WIDTH), D ** -0.5),
        'a_b_in': nrm(ks[7], (N_A_LAYERS, 2 * A_WIDTH), 0.02),
        'a_ln_g': 1.0 + nrm(ks[8], (N_A_LAYERS, A_WIDTH), 0.02),
        'a_ln_b': nrm(ks[9], (N_A_LAYERS, A_WIDTH), 0.02),
        'a_w_s': nrm(ks[10], (N_A_LAYERS, A_GROUPS, A_CHUNK, A_CHUNK), 0.5 * A_CHUNK ** -0.5),
        'a_b_s': 1.0 + nrm(ks[11], (N_A_LAYERS, A_GROUPS, A_CHUNK), 0.02),
        'a_w_out': nrm(ks[12], (N_A_LAYERS, A_WIDTH, D), A_WIDTH ** -0.5),
        'kv_norm': 1.0 + nrm(ks[13], (D,), 0.02),
        'kv_ada_w': nrm(ks[14], (D, 2 * D), 0.2 * D ** -0.5),
        'kv_ada_b': nrm(ks[15], (2 * D,), 0.02),
        'kv_w_k': nrm(ks[16], (D, D), D ** -0.5),
        'kv_w_v': nrm(ks[17], (D, D), D ** -0.5),
        'b_w_q': nrm(ks[18], (N_B_LAYERS, D, D), D ** -0.5),
        'b_w_o': nrm(ks[19], (N_B_LAYERS, D, D), D ** -0.5),
        'moe_router': nrm(ks[20], (DEPTH, D, N_EXPERTS), D ** -0.5),
        'moe_bias': nrm(ks[21], (DEPTH, N_EXPERTS), 0.01),
        'moe_w_gate': nrm(ks[22], (DEPTH, N_EXPERTS, D, EXPERT_DIM), D ** -0.5),
        'moe_w_up': nrm(ks[23], (DEPTH, N_EXPERTS, D, EXPERT_DIM), D ** -0.5),
        'moe_w_down': nrm(ks[24], (DEPTH, N_EXPERTS, EXPERT_DIM, D), EXPERT_DIM ** -0.5),
        'sh_w_gate': nrm(ks[25], (DEPTH, D, SHARED_DIM), D ** -0.5),
        'sh_w_up': nrm(ks[26], (DEPTH, D, SHARED_DIM), D ** -0.5),
        'sh_w_down': nrm(ks[27], (DEPTH, SHARED_DIM, D), SHARED_DIM ** -0.5),
        'final_norm': 1.0 + nrm(ks[28], (D,), 0.02),
    }


def reference(x, c, ada_w, ada_b, norm_mix, norm_ffn, a_w_in, a_b_in, a_ln_g, a_ln_b,
              a_w_s, a_b_s, a_w_out, kv_norm, kv_ada_w, kv_ada_b, kv_w_k, kv_w_v,
              b_w_q, b_w_o, moe_router, moe_bias, moe_w_gate, moe_w_up, moe_w_down,
              sh_w_gate, sh_w_up, sh_w_down, final_norm):
    kv = None
    for i in range(DEPTH):
        sh1, sc1, g1, sh2, sc2, g2 = ada(c, ada_w[i], ada_b[i], 6)
        h = modulate(rmsnorm(x, norm_mix[i]), sh1, sc1)
        if i < N_A_LAYERS:
            y = gmlp_mixer(h, a_w_in[i], a_b_in[i], a_ln_g[i], a_ln_b[i],
                           a_w_s[i], a_b_s[i], a_w_out[i])
        else:
            if kv is None:
                kv = shared_kv(x, c, kv_norm, kv_ada_w, kv_ada_b, kv_w_k, kv_w_v)
            j = i - N_A_LAYERS
            y = moba_mixer(h, b_w_q[j], b_w_o[j], kv[0], kv[1], kv[2])
        x = x + g1 * y
        h = modulate(rmsnorm(x, norm_ffn[i]), sh2, sc2)
        x = x + g2 * moe(h, moe_router[i], moe_bias[i], moe_w_gate[i], moe_w_up[i],
                         moe_w_down[i], sh_w_gate[i], sh_w_up[i], sh_w_down[i])
    return rmsnorm(x, final_norm)
```

```cpp
#include <hip/hip_runtime.h>
#include <hip/hip_bf16.h>
#include <cstdio>
#include <cstdint>
#include <cmath>

#define GAS __attribute__((address_space(1)))
#define LAS __attribute__((address_space(3)))
typedef unsigned short bf16_t;
typedef short bf16x8 __attribute__((ext_vector_type(8)));
typedef float f32x4 __attribute__((ext_vector_type(4)));
typedef float f32x2 __attribute__((ext_vector_type(2)));
typedef unsigned u32x4 __attribute__((ext_vector_type(4)));
typedef unsigned u32x2 __attribute__((ext_vector_type(2)));
typedef __bf16 bf16x2_t __attribute__((ext_vector_type(2)));
typedef GAS unsigned gu32;

constexpr int T = 16384, D = 1024, NBATCH = 8, SEQ = 2048, NH = 16, HD = 64;
constexpr int AW = 2048;
constexpr int NE = 64, TOPK = 8, ED = 256, CAP = 16384;
constexpr float RMS_EPS = 1e-6f, LN_EPS = 1e-5f, ROUTED_SCALE = 2.5f;
constexpr float ATT_C2 = 0.125f * 1.4426950408889634f;
constexpr int NWAVES = 8, NTHREADS = 512;

constexpr size_t MiB = 1u << 20;
constexpr size_t WS_CTL = 0, CTL_ZERO_BYTES = 1 * MiB;
constexpr size_t WS_MOD = 1 * MiB;
constexpr size_t WS_VPART = 2 * MiB;
constexpr size_t WS_TOKLIST = 6 * MiB, WS_WLIST = 10 * MiB;
constexpr size_t WS_WIN_T = 14 * MiB;
constexpr size_t WS_WOUT_T = 22 * MiB;
constexpr size_t WS_WSP = 26 * MiB;
constexpr size_t WS_WQKV_T = 27 * MiB;
constexpr size_t WS_WO_T = 33 * MiB;
constexpr size_t WS_GU = 36 * MiB;
constexpr size_t WS_DN = 101 * MiB;
constexpr size_t WS_H = 134 * MiB;
constexpr size_t WS_SCR = 214 * MiB;
constexpr size_t WS_END = 470 * MiB;
constexpr int CW_TMO = 0, CW_CODE = 1, CW_BAR = 4096, CW_CNT = 8192;
constexpr size_t CTL_KMEAN = 65536;
constexpr int MOD_L = 8 * 6144;

constexpr int RING_BYTES = 131072;
constexpr int LDSCTL_OFF = RING_BYTES, MISC_OFF = LDSCTL_OFF + 320;
constexpr int LDS_AUX = RING_BYTES + 1024;
constexpr int LDS_BYTES = 147456;

#define RLX_AGENT __ATOMIC_RELAXED, __HIP_MEMORY_SCOPE_AGENT
#define LDS_WAIT() asm volatile("s_waitcnt lgkmcnt(0)" ::: "memory")
#define VM_WAIT() asm volatile("s_waitcnt vmcnt(0)" ::: "memory")

__device__ __forceinline__ unsigned f2bf(float f) { unsigned u = __builtin_bit_cast(unsigned, f); return (u + 0x7fffu + ((u >> 16) & 1u)) >> 16; }
__device__ __forceinline__ unsigned pk2(float lo, float hi) { f32x2 v = {lo, hi}; bf16x2_t b = __builtin_convertvector(v, bf16x2_t); return __builtin_bit_cast(unsigned, b); }
__device__ __forceinline__ float bf_lo(unsigned w) { return __uint_as_float(w << 16); }
__device__ __forceinline__ float bf_hi(unsigned w) { return __uint_as_float(w & 0xffff0000u); }
__device__ __forceinline__ float wave_sum(float v) {
#pragma unroll
    for (int o = 1; o < 64; o <<= 1) v += __shfl_xor(v, o);
    return v;
}
__device__ __forceinline__ float gelu_tanh(float x) {
    const float t = x * x, inner = x * (0.7978845608f + 0.0356774081f * t);
    const float e = __builtin_amdgcn_exp2f(-2.885390082f * inner);
    return x * __builtin_amdgcn_rcpf(1.0f + e);
}
__device__ __forceinline__ float silu_f(float x) { return x / (1.0f + __expf(-x)); }
#define XB_TMO      128
#define XB_XCNT(j)  (256  + 64 * (j))
#define XB_XSUB(j)  (1280 + 64 * (j))
#define XB_XGEN(j)  (2304 + 64 * (j))
#define XB_TOP      3328
#define XB_TOPGEN   3392
#define XCD_BAR_WORDS 3456
#define XB_SPIN_CAP (1u << 20)
__device__ __forceinline__ unsigned xb_ld(unsigned* p)              { return __hip_atomic_load(p, __ATOMIC_RELAXED, __HIP_MEMORY_SCOPE_AGENT); }
__device__ __forceinline__ unsigned xb_add(unsigned* p, unsigned v) { return __hip_atomic_fetch_add(p, v, __ATOMIC_RELAXED, __HIP_MEMORY_SCOPE_AGENT); }
__device__ __forceinline__ unsigned xb_xcc_id() { return (unsigned)__builtin_amdgcn_s_getreg((3 << 11) | 20) & 0xFu; }
#define XB_SPIN(cond, bar) do { unsigned _sp = 0; while (cond) { __builtin_amdgcn_s_sleep(1); \
    if ((++_sp & 255u) == 0u) { if (xb_ld(&(bar)[XB_TMO])) break; if (_sp > XB_SPIN_CAP) { atomicAdd(&(bar)[XB_TMO], 1u); break; } } } } while (0)

struct XcdBarrier {
    unsigned* bar; unsigned x;
    volatile LAS unsigned* st;
};

__device__ __forceinline__ XcdBarrier xcd_barrier_post(unsigned* bar, volatile LAS unsigned* st) {
    XcdBarrier b; b.bar = bar; b.x = xb_xcc_id(); b.st = st;
    if (threadIdx.x == 0) (void)xb_add(&bar[XB_XCNT(b.x)], 1u);
    return b;
}
__device__ __forceinline__ void xcd_barrier_complete(unsigned* bar, unsigned x, unsigned& nloc, unsigned& nx) {
    const unsigned G = gridDim.x * gridDim.y * gridDim.z;
    unsigned sum, cnt, mine, sp = 0u;
    for (;;) {
        sum = 0u; cnt = 0u; mine = 0u;
#pragma unroll
        for (unsigned j = 0; j < 16; ++j) { const unsigned c = xb_ld(&bar[XB_XCNT(j)]); sum += c; cnt += (c > 0u) ? 1u : 0u; mine = (j == x) ? c : mine; }
        if (sum == G) break;
        __builtin_amdgcn_s_sleep(1);
        if ((++sp & 255u) == 0u) { if (xb_ld(&bar[XB_TMO])) break; if (sp > XB_SPIN_CAP) { atomicAdd(&bar[XB_TMO], 1u); break; } }
    }
    nloc = mine > 0u ? mine : 1u; nx = cnt > 0u ? cnt : 1u;
}

__device__ __forceinline__ void xcd_barrier(const XcdBarrier& b) {
    asm volatile("s_waitcnt vmcnt(0)" ::: "memory");
    __syncthreads();
    if (threadIdx.x == 0) {
        unsigned* bar = b.bar;
        __builtin_amdgcn_s_waitcnt(0);
        unsigned nloc = b.st[0], nx = b.st[1];
        if (nloc == 0u) { xcd_barrier_complete(bar, b.x, nloc, nx); b.st[0] = nloc; b.st[1] = nx; }
        const unsigned old = xb_add(&bar[XB_XSUB(b.x)], 1u);
        const unsigned gen = old / nloc;
        if (old + 1u == (gen + 1u) * nloc) {
            __builtin_amdgcn_fence(__ATOMIC_RELEASE, "agent");
            asm volatile("s_waitcnt vmcnt(0)" ::: "memory");
            const unsigned og = xb_add(&bar[XB_TOP], 1u);
            const unsigned tg = og / nx;
            if (og + 1u == (tg + 1u) * nx) xb_add(&bar[XB_TOPGEN], 1u);
            else XB_SPIN(xb_ld(&bar[XB_TOPGEN]) == tg, bar);
            __builtin_amdgcn_fence(__ATOMIC_ACQUIRE, "agent");
            xb_add(&bar[XB_XGEN(b.x)], 1u);
            asm volatile("s_waitcnt vmcnt(0)" ::: "memory");
        } else {
            XB_SPIN(xb_ld(&bar[XB_XGEN(b.x)]) == gen, bar);
            __builtin_amdgcn_fence(__ATOMIC_ACQUIRE, "agent");
            asm volatile("s_waitcnt vmcnt(0)" ::: "memory");
        }
    }
    __syncthreads();
}

__host__ __device__ __forceinline__ int perm32(int rho) { const int n = rho >> 4, i = rho & 15; return 8 * (i >> 2) + 4 * n + (i & 3); }

struct Unit { int pm, pn, arow, brow, e, nvalid, lbase; };

constexpr int NXCD = 8, WGM = 8;
struct DenseSched {
    int nM, nN, nwg, G, c, a_split_pn, a_split_rows;
    __device__ __forceinline__ void init(int M, int N, int G_, int c_, int spn = 1 << 30, int srows = 0) { nM = M / 256; nN = N / 256; nwg = nM * nN; G = G_; c = c_; a_split_pn = spn; a_split_rows = srows; }
    __device__ __forceinline__ bool next(int i, Unit& u) const {
        const long L = (long)i * G + c; if (L >= nwg) return false;
        int wgid = (int)L; { const int q = nwg / NXCD, r = nwg % NXCD, xcd = wgid % NXCD, off = wgid / NXCD; wgid = (xcd < r ? xcd * (q + 1) : r * (q + 1) + (xcd - r) * q) + off; }
        const int nig = WGM * nN, gid = wgid / nig, fm = gid * WGM, gsz = (nM - fm) < WGM ? (nM - fm) : WGM;
        u.pm = fm + ((wgid % nig) % gsz); u.pn = (wgid % nig) / gsz;
        u.arow = u.pm * 256 + (u.pn >= a_split_pn ? a_split_rows : 0); u.brow = u.pn * 256; u.e = -1; u.nvalid = 256; u.lbase = 0; return true;
    }
    __device__ __forceinline__ int a_row(const Unit& u, int r) const { return u.arow + r; }
};
template <bool GATE_UP> struct MoeSched {
    const LAS int* tb; const LAS int* cnt; const int* toklist; int G, c, ncol, nunits;
    __device__ __forceinline__ void init(const LAS int* tb_, const LAS int* cnt_, const int* tl, int G_, int c_) { tb = tb_; cnt = cnt_; toklist = tl; G = G_; c = c_; ncol = GATE_UP ? 2 : 4; nunits = tb_[65] * ncol; }
    __device__ __forceinline__ bool next(int i, Unit& u) const {
        const int L = i * G + c; if (L >= nunits) return false;
        const int rt = L / ncol; u.pn = L % ncol; u.pm = rt;
        int e = 0;
#pragma unroll 1
        for (int j = 64; j > 0; j >>= 1) if (e + j <= 64 && tb[e + j] <= rt) e += j;
        while (e < 64 && tb[e + 1] <= rt) ++e;
        u.e = e;
        const int ti = rt - tb[e];
        if (e < 64) { const int left = cnt[e] - ti * 256; u.nvalid = left < 256 ? left : 256; u.lbase = e * CAP + ti * 256; u.arow = GATE_UP ? 0 : rt * 256; }
        else { u.nvalid = 256; u.lbase = 0; u.arow = GATE_UP ? ti * 256 : rt * 256; }
        u.brow = GATE_UP ? (e * 512 + u.pn * 256) : (e * 1024 + u.pn * 256);
        return true;
    }
    __device__ __forceinline__ int a_row(const Unit& u, int r) const {
        if (!GATE_UP) return u.arow + r;
        if (u.e == 64) return u.arow + r;
        return (r < u.nvalid) ? (toklist[u.lbase + r] >> 3) : 0;
    }
};

template <class Epi, class Sched>
__device__ __forceinline__ void gemm_ref(const bf16_t* A, const bf16_t* Bt, int K, const Sched& S, const Epi& E) {
    const int tid = threadIdx.x, wid = __builtin_amdgcn_readfirstlane(tid >> 6), lane = tid & 63, wr = wid >> 2, wc = wid & 3, fr = lane & 15, fq = lane >> 4;
    Unit u;
    for (int i = 0; S.next(i, u); ++i) {
        f32x4 acc[2][2][4][2];
#pragma unroll
        for (int a = 0; a < 2; ++a)
#pragma unroll
            for (int b = 0; b < 2; ++b)
#pragma unroll
                for (int m = 0; m < 4; ++m)
#pragma unroll
                    for (int n = 0; n < 2; ++n) acc[a][b][m][n] = (f32x4){0.f, 0.f, 0.f, 0.f};
        unsigned aoff[2][4], boff[2][2];
#pragma unroll
        for (int ai = 0; ai < 2; ++ai)
#pragma unroll
            for (int m = 0; m < 4; ++m) aoff[ai][m] = (unsigned)S.a_row(u, 128 * ai + 64 * wr + 16 * m + fr) * (unsigned)K + 8u * fq;
#pragma unroll
        for (int bj = 0; bj < 2; ++bj)
#pragma unroll
            for (int n = 0; n < 2; ++n) boff[bj][n] = (unsigned)(u.brow + 128 * bj + 32 * wc + (Epi::PERM ? perm32(16 * n + fr) : 16 * n + fr)) * (unsigned)K + 8u * fq;
#pragma unroll 1
        for (int kk = 0; kk < K; kk += 32) {
            bf16x8 af[2][4], bfr[2][2];
#pragma unroll
            for (int ai = 0; ai < 2; ++ai)
#pragma unroll
                for (int m = 0; m < 4; ++m) af[ai][m] = *(const bf16x8*)(A + (size_t)aoff[ai][m] + kk);
#pragma unroll
            for (int bj = 0; bj < 2; ++bj)
#pragma unroll
                for (int n = 0; n < 2; ++n) bfr[bj][n] = *(const bf16x8*)(Bt + (size_t)boff[bj][n] + kk);
#pragma unroll
            for (int ai = 0; ai < 2; ++ai)
#pragma unroll
                for (int bj = 0; bj < 2; ++bj)
#pragma unroll
                    for (int m = 0; m < 4; ++m)
#pragma unroll
                        for (int n = 0; n < 2; ++n) acc[ai][bj][m][n] = __builtin_amdgcn_mfma_f32_16x16x32_bf16(bfr[bj][n], af[ai][m], acc[ai][bj][m][n], 0, 0, 0);
        }
        E(acc, u, wr, wc, fr, fq);
    }
}

struct EpiGemm1 {
    static constexpr bool PERM = true;
    bf16_t* U; bf16_t* VT; float* vpart; const float* bias;
    __device__ __forceinline__ void operator()(const f32x4 (&acc)[2][2][4][2], const Unit& u, int wr, int wc, int fr, int fq) const {
        const int colt = u.pn * 256; const bool isv = colt >= AW;
        f32x4 bv[2][2];
#pragma unroll
        for (int bj = 0; bj < 2; ++bj)
#pragma unroll
            for (int n = 0; n < 2; ++n) bv[bj][n] = *(const f32x4*)(bias + colt + 128 * bj + 32 * wc + 8 * fq + 4 * n);
#pragma unroll
        for (int ai = 0; ai < 2; ++ai)
#pragma unroll
            for (int m = 0; m < 4; ++m) {
                const int row = u.pm * 256 + 128 * ai + 64 * wr + 16 * m + fr;
                float s1 = 0.f, s2 = 0.f;
#pragma unroll
                for (int bj = 0; bj < 2; ++bj) {
                    float v[8];
#pragma unroll
                    for (int n = 0; n < 2; ++n)
#pragma unroll
                        for (int j = 0; j < 4; ++j) v[4 * n + j] = gelu_tanh(acc[ai][bj][m][n][j] + bv[bj][n][j]);
                    const int col = colt + 128 * bj + 32 * wc + 8 * fq;
                    if (!isv) {
                        u32x4 w; w.x = pk2(v[0], v[1]); w.y = pk2(v[2], v[3]); w.z = pk2(v[4], v[5]); w.w = pk2(v[6], v[7]);
                        *(u32x4*)(U + (size_t)row * AW + col) = w;
                    } else {
                        bf16_t* vt = VT + ((size_t)(row >> 7) * AW + (col - AW)) * 128 + (row & 127);
#pragma unroll
                        for (int j = 0; j < 8; ++j) { vt[(size_t)j * 128] = (bf16_t)f2bf(v[j]); s1 += v[j]; s2 += v[j] * v[j]; }
                    }
                }
                if (isv) {
                    s1 += __shfl_xor(s1, 16); s1 += __shfl_xor(s1, 32); s2 += __shfl_xor(s2, 16); s2 += __shfl_xor(s2, 32);
                    if (fq == 0) { float* p = vpart + ((size_t)row * 32 + (u.pn - 8) * 4 + wc) * 2; *(f32x2*)p = (f32x2){s1, s2}; }
                }
            }
    }
};
struct EpiResid {
    static constexpr bool PERM = false;
    const float* base; float* out; const float* gate;
    int gstride;
    __device__ __forceinline__ void operator()(const f32x4 (&acc)[2][2][4][2], const Unit& u, int wr, int wc, int fr, int fq) const {
        const int b = (u.pm * 256) / SEQ;
        f32x4 gv[2][2];
#pragma unroll
        for (int bj = 0; bj < 2; ++bj)
#pragma unroll
            for (int n = 0; n < 2; ++n) gv[bj][n] = *(const f32x4*)(gate + (size_t)b * gstride + u.pn * 256 + 128 * bj + 32 * wc + 16 * n + 4 * fq);
#pragma unroll
        for (int ai = 0; ai < 2; ++ai)
#pragma unroll
            for (int m = 0; m < 4; ++m) {
                const size_t off = (size_t)(u.pm * 256 + 128 * ai + 64 * wr + 16 * m + fr) * D + u.pn * 256 + 32 * wc + 4 * fq;
#pragma unroll
                for (int bj = 0; bj < 2; ++bj)
#pragma unroll
                    for (int n = 0; n < 2; ++n) { const f32x4 bs = *(const f32x4*)(base + off + 128 * bj + 16 * n); *(f32x4*)(out + off + 128 * bj + 16 * n) = bs + gv[bj][n] * acc[ai][bj][m][n]; }
            }
    }
};
struct EpiGateUp {
    static constexpr bool PERM = true;
    bf16_t* Hb;
    __device__ __forceinline__ void operator()(const f32x4 (&acc)[2][2][4][2], const Unit& u, int wr, int wc, int fr, int fq) const {
#pragma unroll
        for (int ai = 0; ai < 2; ++ai)
#pragma unroll
            for (int m = 0; m < 4; ++m) {
                const int r = 128 * ai + 64 * wr + 16 * m + fr;
                float v[8];
#pragma unroll
                for (int n = 0; n < 2; ++n)
#pragma unroll
                    for (int j = 0; j < 4; ++j) { const float g = acc[ai][0][m][n][j], up = acc[ai][1][m][n][j]; v[4 * n + j] = silu_f(g) * up; }
                u32x4 w; w.x = pk2(v[0], v[1]); w.y = pk2(v[2], v[3]); w.z = pk2(v[4], v[5]); w.w = pk2(v[6], v[7]);
                *(u32x4*)(Hb + (size_t)(u.pm * 256 + r) * ED + u.pn * 128 + 32 * wc + 8 * fq) = w;
            }
    }
};
struct EpiDown {
    static constexpr bool PERM = true;
    bf16_t* Y; float* X; const int* toklist; const float* wlist; const float* gate; int gstride; const LAS int* tb;
    __device__ __forceinline__ void operator()(const f32x4 (&acc)[2][2][4][2], const Unit& u, int wr, int wc, int fr, int fq) const {
        const int colb = u.pn * 256 + 32 * wc + 8 * fq;
        if (u.e < 64) {
#pragma unroll
            for (int ai = 0; ai < 2; ++ai)
#pragma unroll
                for (int m = 0; m < 4; ++m) {
                    const int r = 128 * ai + 64 * wr + 16 * m + fr;
                    if (r < u.nvalid) {
                        const int ent = toklist[u.lbase + r]; const float w = wlist[u.lbase + r];
#pragma unroll
                        for (int bj = 0; bj < 2; ++bj) { const f32x4 a0 = acc[ai][bj][m][0] * w, a1 = acc[ai][bj][m][1] * w;
                            u32x4 o; o.x = pk2(a0[0], a0[1]); o.y = pk2(a0[2], a0[3]); o.z = pk2(a1[0], a1[1]); o.w = pk2(a1[2], a1[3]);
                            *(u32x4*)(Y + (size_t)ent * D + colb + 128 * bj) = o; }
                    }
                }
        } else {
            const int t0 = (u.pm - tb[64]) * 256; const int b = t0 / SEQ;
#pragma unroll
            for (int ai = 0; ai < 2; ++ai)
#pragma unroll
                for (int m = 0; m < 4; ++m) {
                    const int r = 128 * ai + 64 * wr + 16 * m + fr;
                    float* xr = X + (size_t)(t0 + r) * D + colb;
#pragma unroll
                    for (int bj = 0; bj < 2; ++bj)
#pragma unroll
                        for (int n = 0; n < 2; ++n) { const f32x4 g = *(const f32x4*)(gate + (size_t)b * gstride + colb + 128 * bj + 4 * n); f32x4* p = (f32x4*)(xr + 128 * bj + 4 * n); *p = *p + g * acc[ai][bj][m][n]; }
                }
        }
    }
};
struct EpiQKV {
    static constexpr bool PERM = true;
    bf16_t* Q; float* kmean;
    __device__ __forceinline__ void operator()(const f32x4 (&acc)[2][2][4][2], const Unit& u, int wr, int wc, int fr, int fq) const {
        const int which = u.pn >> 2, colt = (u.pn & 3) * 256;
        bf16_t* base = Q + (size_t)which * ((size_t)T * D);
        const float sc = which == 0 ? ATT_C2 : 1.0f;
        const int col0 = colt + 32 * wc + 8 * fq;
        float cs[2][8];
#pragma unroll
        for (int bj = 0; bj < 2; ++bj)
#pragma unroll
            for (int j = 0; j < 8; ++j) cs[bj][j] = 0.f;
#pragma unroll
        for (int ai = 0; ai < 2; ++ai)
#pragma unroll
            for (int m = 0; m < 4; ++m) {
                bf16_t* rowp = base + (size_t)(u.pm * 256 + 128 * ai + 64 * wr + 16 * m + fr) * D + col0;
#pragma unroll
                for (int bj = 0; bj < 2; ++bj) { const f32x4 v0 = acc[ai][bj][m][0] * sc, v1 = acc[ai][bj][m][1] * sc;
                    u32x4 w; w.x = pk2(v0[0], v0[1]); w.y = pk2(v0[2], v0[3]); w.z = pk2(v1[0], v1[1]); w.w = pk2(v1[2], v1[3]);
                    *(u32x4*)(rowp + 128 * bj) = w;
#pragma unroll
                    for (int j = 0; j < 4; ++j) { cs[bj][j] += v0[j]; cs[bj][4 + j] += v1[j]; } }
            }
        if (which == 1) {
#pragma unroll
            for (int bj = 0; bj < 2; ++bj)
#pragma unroll
                for (int j = 0; j < 8; ++j) { float s = cs[bj][j]; s += __shfl_xor(s, 1); s += __shfl_xor(s, 2); s += __shfl_xor(s, 4); s += __shfl_xor(s, 8); cs[bj][j] = s; }
            if (fr == 0) {
                const int b = u.pm >> 3, blk = u.pm & 7;
#pragma unroll
                for (int bj = 0; bj < 2; ++bj)
#pragma unroll
                    for (int j = 0; j < 8; ++j) { const int c = col0 + 128 * bj + j, h = c >> 6, d = c & 63;
                        atomicAdd(kmean + (((size_t)b * NH + h) * 8 + blk) * 64 + d, cs[bj][j] * (1.0f / 256.0f)); }
            }
        }
    }
};
#include <hip/hip_bf16.h>
#include <cmath>
namespace attn_body {
using bf16=__hip_bfloat16;
using bf16x8=__attribute__((ext_vector_type(8)))short;
using s16x4=__attribute__((ext_vector_type(4)))short;
using f32x16=__attribute__((ext_vector_type(16)))float;
using u32x4=__attribute__((ext_vector_type(4)))unsigned;
constexpr int BATCH=8,NHEAD=16,SEQ=2048,D=64,DM=NHEAD*D;
constexpr int NW=8,QBLK=32,QB=QBLK*NW,KVBLK=64,NQB=SEQ/QB;
constexpr int ATTN_PITCH=DM, ATTN_UNIT_ROWS=QB;
__device__ __forceinline__ int crow(int r,int hi){return (r&3)+8*(r>>2)+4*hi;}
#define SBAR() __builtin_amdgcn_sched_barrier(0)
__device__ __forceinline__ void cmask(f32x16&p0,f32x16&p1,int jb,int qrel,int hi){
  const float NEG=-INFINITY; int kb=64*jb+4*hi;
  #pragma unroll
  for(int r=0;r<16;++r){int kv=kb+(r&3)+8*(r>>2); if(kv>qrel)p0[r]=NEG; if(kv+32>qrel)p1[r]=NEG;}
}

constexpr int NSLOT=3, SLOTB=8192;
constexpr int LDS_K=0, LDS_V=NSLOT*SLOTB, LDS_WS=2*NSLOT*SLOTB, LDS_OST=LDS_WS+NW*64*4, LDS_BYTES=LDS_OST+NW*4096;
constexpr float C2=0.125f*1.4426950408889634f;
__device__ __forceinline__ void glds16(const void*gsrc,unsigned lds_dst){unsigned keep;
  asm volatile("s_mov_b32 %0, m0\n\ts_mov_b32 m0, %2\n\ts_nop 0\n\tglobal_load_lds_dwordx4 %1, off\n\ts_mov_b32 m0, %0":"=&s"(keep):"v"(gsrc),"s"(lds_dst):"memory");}
__device__ __forceinline__ float max3f(float a,float b,float c){float r;asm("v_max3_f32 %0, %1, %2, %3":"=v"(r):"v"(a),"v"(b),"v"(c));return r;}
__device__ __forceinline__ float max2f(float a,float b){float r;asm("v_max_f32_e32 %0, %1, %2":"=v"(r):"v"(a),"v"(b));return r;}
__device__ __forceinline__ float fadd_s(float a,float b){float r;asm("v_add_f32_e32 %0, %1, %2":"=v"(r):"v"(a),"v"(b));return r;}
__device__ __forceinline__ float fsub_s(float a,float b){float r;asm("v_sub_f32_e32 %0, %1, %2":"=v"(r):"v"(a),"v"(b));return r;}
typedef float f32x2_t __attribute__((ext_vector_type(2))); typedef float f32x4_t __attribute__((ext_vector_type(4)));
__device__ __forceinline__ float bf2f(short v){return __uint_as_float(((unsigned)(unsigned short)v)<<16);} typedef __bf16 bf16x2_t __attribute__((ext_vector_type(2)));
__device__ __forceinline__ unsigned cvtpk_s(float lo,float hi){f32x2_t v={lo,hi};bf16x2_t b=__builtin_convertvector(v,bf16x2_t);return __builtin_bit_cast(unsigned,b);}
#define WAIT_BAR(N) asm volatile("s_waitcnt vmcnt(" #N ") lgkmcnt(0)\n\ts_barrier":::"memory")

__device__ __forceinline__ void qkt(f32x16&p0,f32x16&p1,const char*Kslot,const bf16x8*qr,const f32x16&negm,int r32,int hi){
  const char*kb=Kslot+hi*1024+r32*16;
  #pragma unroll
  for(int d0=0;d0<4;++d0){
    const bf16x8 b0=*reinterpret_cast<const bf16x8*>(kb+d0*2048);
    const bf16x8 b1=*reinterpret_cast<const bf16x8*>(kb+d0*2048+512);
    if(d0==0){p0=__builtin_amdgcn_mfma_f32_32x32x16_bf16(b0,qr[0],negm,0,0,0);p1=__builtin_amdgcn_mfma_f32_32x32x16_bf16(b1,qr[0],negm,0,0,0);}
    else{p0=__builtin_amdgcn_mfma_f32_32x32x16_bf16(b0,qr[d0],p0,0,0,0);p1=__builtin_amdgcn_mfma_f32_32x32x16_bf16(b1,qr[d0],p1,0,0,0);}}
}
typedef __attribute__((address_space(3))) const char* lds_cptr;
typedef short v4i16_t __attribute__((ext_vector_type(4)));
__device__ __forceinline__ void kload8(bf16x8*kf,lds_cptr kp){
  kf[0]=*(const __attribute__((address_space(3))) bf16x8*)(kp);      kf[1]=*(const __attribute__((address_space(3))) bf16x8*)(kp+512);
  kf[2]=*(const __attribute__((address_space(3))) bf16x8*)(kp+2048); kf[3]=*(const __attribute__((address_space(3))) bf16x8*)(kp+2560);
  kf[4]=*(const __attribute__((address_space(3))) bf16x8*)(kp+4096); kf[5]=*(const __attribute__((address_space(3))) bf16x8*)(kp+4608);
  kf[6]=*(const __attribute__((address_space(3))) bf16x8*)(kp+6144); kf[7]=*(const __attribute__((address_space(3))) bf16x8*)(kp+6656);
}
__device__ __forceinline__ void kload2(bf16x8*kf,lds_cptr kp,int j){ kf[2*j]=*(const __attribute__((address_space(3))) bf16x8*)(kp+j*2048); kf[2*j+1]=*(const __attribute__((address_space(3))) bf16x8*)(kp+j*2048+512); }
__device__ __forceinline__ s16x4 vtr(lds_cptr p){ return __builtin_bit_cast(s16x4,__builtin_amdgcn_ds_read_tr16_b64_v4i16((__attribute__((address_space(3))) v4i16_t*)p)); }
__device__ __forceinline__ float rowmax(const f32x16&p0,const f32x16&p1){
  float a=max3f(p0[0],p0[1],p1[0]),b=max3f(p0[2],p0[3],p1[1]);a=max3f(a,p1[2],p1[3]);
  #pragma unroll
  for(int r=4;r<16;r+=4){a=max3f(a,p0[r],p0[r+1]);b=max3f(b,p0[r+2],p0[r+3]);a=max3f(a,p1[r],p1[r+1]);b=max3f(b,p1[r+2],p1[r+3]);}
  const float m=max2f(a,b);
  auto rr=__builtin_amdgcn_permlane32_swap(__float_as_uint(m),__float_as_uint(m),false,false);
  return max2f(__uint_as_float(rr[0]),__uint_as_float(rr[1]));
}
__device__ __forceinline__ void pv(f32x16*o,int vb,bf16x8 pa0,bf16x8 pa1,bf16x8 pa2,bf16x8 pa3){
  #pragma unroll
  for(int d0=0;d0<2;++d0){s16x4 lo[4],hi[4];
    #pragma unroll
    for(int ks=0;ks<4;++ks){
      asm volatile("ds_read_b64_tr_b16 %0,%1 offset:%c2":"=&v"(lo[ks]):"v"(vb),"i"(d0*4096+ks*1024):"memory");
      asm volatile("ds_read_b64_tr_b16 %0,%1 offset:%c2":"=&v"(hi[ks]):"v"(vb),"i"(d0*4096+ks*1024+512):"memory");}
    asm volatile("s_waitcnt lgkmcnt(0)":::"memory");SBAR();
    #define PK(k) (bf16x8){lo[k][0],lo[k][1],lo[k][2],lo[k][3],hi[k][0],hi[k][1],hi[k][2],hi[k][3]}
    o[d0]=__builtin_amdgcn_mfma_f32_32x32x16_bf16(pa0,PK(0),o[d0],0,0,0);
    o[d0]=__builtin_amdgcn_mfma_f32_32x32x16_bf16(pa1,PK(1),o[d0],0,0,0);
    o[d0]=__builtin_amdgcn_mfma_f32_32x32x16_bf16(pa2,PK(2),o[d0],0,0,0);
    o[d0]=__builtin_amdgcn_mfma_f32_32x32x16_bf16(pa3,PK(3),o[d0],0,0,0);
    #undef PK
  }
}

#ifndef ATTN_STORE16
#define ATTN_STORE16(p,v) (*(u32x4*)(p)=(v))
#endif
template<int THRL> __device__ __forceinline__ void attn_unit(int b,int h,int qb,const bf16*Q,const bf16*__restrict__ K,const bf16*__restrict__ V,bf16*O,const float*KM,char*shm){
  const int tid=threadIdx.x,lane=tid&63,r32=lane&31,hi=lane>>5; const int wid=__builtin_amdgcn_readfirstlane(tid>>6);
  const long rowbase=(long)b*SEQ; const int q0=qb*QB;
  const bf16*Qw=Q+(rowbase+q0+wid*QBLK)*DM+h*D;
  const bf16*Kh=K+rowbase*DM+h*D,*Vh=V+rowbase*DM+h*D;
  const unsigned lds0=(unsigned)(uintptr_t)shm;
  float*wsf=(float*)(shm+LDS_WS)+wid*64;
  const bf16*ksrc=Kh+(long)lane*DM+wid*8;
  const bf16*vsrc=Vh+(long)(16*(wid&3)+(lane>>2))*DM+(wid>>2)*32+(lane&3)*8;
  const unsigned kdst=lds0+LDS_K+wid*1024, vdst=lds0+LDS_V+wid*1024;
  #define PHYS(t) (((t)<4)?(NT-4+(t)):((t)-4))
  #define DMA_K(t,slot) glds16(ksrc+(long)PHYS(t)*KVBLK*DM,(unsigned)__builtin_amdgcn_readfirstlane(kdst+(slot)))
  #define DMA_V(t,slot) glds16(vsrc+(long)PHYS(t)*KVBLK*DM,(unsigned)__builtin_amdgcn_readfirstlane(vdst+(slot)))
  const int vb0=(int)(lds0+LDS_V)+((lane>>4)&1)*32+(lane&3)*8+(4*hi+((lane&15)>>2))*64;
  const char*Kbase=shm+LDS_K; bf16x8 kf[8];
  const lds_cptr shm3=(lds_cptr)shm; const lds_cptr kp0=shm3+LDS_K+hi*1024+r32*16; const lds_cptr vp0=shm3+LDS_V+((lane>>4)&1)*32+(lane&3)*8+(4*hi+((lane&15)>>2))*64;
  const int NT=(q0+QB)/KVBLK;
  DMA_K(0,0);DMA_V(0,0);DMA_K(1,SLOTB);
  bf16x8 qr[4];
  #pragma unroll
  for(int d0=0;d0<4;++d0)qr[d0]=*reinterpret_cast<const bf16x8*>(&Qw[(long)r32*DM+d0*16+hi*8]);
  int selmask=(1<<qb)-1;
  if(qb>3){
    float gt[7];
    #pragma unroll
    for(int kb=0;kb<7;++kb){ float a=0.f;
      if(kb<qb){ const float*km=KM+(((long)b*NHEAD+h)*8+kb)*64+hi*8;
        #pragma unroll
        for(int d0=0;d0<4;++d0){ const f32x4_t k0=*reinterpret_cast<const f32x4_t*>(km+d0*16), k1=*reinterpret_cast<const f32x4_t*>(km+d0*16+4);
          a+=bf2f(qr[d0][0])*k0[0]+bf2f(qr[d0][1])*k0[1]+bf2f(qr[d0][2])*k0[2]+bf2f(qr[d0][3])*k0[3]+bf2f(qr[d0][4])*k1[0]+bf2f(qr[d0][5])*k1[1]+bf2f(qr[d0][6])*k1[2]+bf2f(qr[d0][7])*k1[3]; } }
      a+=__shfl_xor(a,32); gt[kb]=a; }
    selmask=0;
    #pragma unroll
    for(int kb=0;kb<7;++kb){ int rank=0;
      #pragma unroll
      for(int k2=0;k2<7;++k2){ if(k2!=kb&&k2<qb){ rank+=((gt[k2]>gt[kb])||(gt[k2]==gt[kb]&&k2<kb))?1:0; } }
      if(kb<qb&&rank<3)selmask|=(1<<kb); }
  }
  float mhat=0.f,l_reg=0.f;f32x16 o[2];o[0]=f32x16{};o[1]=f32x16{};const f32x16 zc=f32x16{};
  const int qrel=wid*QBLK+r32;
  #define CMASK(P0,P1,t) do{int jb_=(t); if(jb_<4)cmask(P0,P1,jb_,qrel,hi); else if(!((selmask>>((jb_-4)>>2))&1)){ _Pragma("unroll") for(int r_=0;r_<16;++r_){P0[r_]=-INFINITY;P1[r_]=-INFINITY;} } }while(0)
  bool resc=false;
  #define START(P0,P1) do{ const float rm=rowmax(P0,P1); resc=false; \
    { const float dl=rm; mhat=fadd_s(mhat,dl); \
      _Pragma("unroll") for(int r=0;r<16;++r){P0[r]=fsub_s(P0[r],dl);P1[r]=fsub_s(P1[r],dl);} \
      } \
    _Pragma("unroll") for(int r=0;r<16;++r)P0[r]=__builtin_amdgcn_exp2f(P0[r]); }while(0)
  #define RESC() do{ if(resc){ asm volatile("s_waitcnt lgkmcnt(0)":::"memory"); \
      _Pragma("unroll") for(int d_=0;d_<2;++d_) _Pragma("unroll") for(int r=0;r<16;++r)o[d_][r]*=wsf[crow(r,hi)]; } }while(0)
  f32x16 pA0,pA1,pB0,pB1;
  int sl_prev=0,sl_cur=0,sl_next=SLOTB;
  #define ROT() do{sl_prev=sl_cur;sl_cur=sl_next;sl_next=(sl_next==(NSLOT-1)*SLOTB)?0:sl_next+SLOTB;}while(0)
  DMA_K(2,2*SLOTB);
  WAIT_BAR(3);
  qkt(pA0,pA1,Kbase,qr,zc,r32,hi);asm volatile("s_nop 15\n\ts_nop 7":"+v"(pA0),"+v"(pA1));CMASK(pA0,pA1,0);
  START(pA0,pA1);
  _Pragma("unroll") for(int r=0;r<16;++r)pA1[r]=__builtin_amdgcn_exp2f(pA1[r]);
  WAIT_BAR(0);
  DMA_K(3,0);DMA_V(1,SLOTB);
  ROT();
  kload8(kf,kp0+sl_cur);
  WAIT_BAR(2);
  s16x4 vlo[8],vhi[8]; u32x4 pw0,pw1,pw2,pw3;
  #define PKW(P,B) cvtpk_s(P[B],P[B+1])
  #define PAF(k) __builtin_bit_cast(bf16x8,pw##k)
  #define VFR(i) (bf16x8){vlo[i][0],vlo[i][1],vlo[i][2],vlo[i][3],vhi[i][0],vhi[i][1],vhi[i][2],vhi[i][3]}
  #define PIN(x) asm volatile("":"+v"(x))
  #define MX3(a,b,c) __builtin_fmaxf(__builtin_fmaxf((a),(b)),(c))
  #define GAPA(MF,A0,A1,A2,A3,W0,W1,PW) do{ MF; sacc+=A0; sacc+=A1; sacc+=A2; sacc+=A3; PIN(sacc); W0; W1; PIN(PW); SBAR(); }while(0)
  #define EX(v) __builtin_amdgcn_exp2f(v)
  #define GAPB(MF,X,B) do{ MF; X[B]=EX(X[B]-mhat); X[B+1]=EX(X[B+1]-mhat); X[B+2]=EX(X[B+2]-mhat); X[B+3]=EX(X[B+3]-mhat); PIN(X); SBAR(); }while(0)
  #define VRD(i) do{ vlo[i]=vtr(vp_+(((i)>>2)*4096+((i)&3)*1024)); vhi[i]=vtr(vp_+(((i)>>2)*4096+((i)&3)*1024+512)); }while(0)
  #define KRD(G,j) do{ if(G){ kload2(kf,kp0+sl_next,j); SBAR(); } }while(0)
  #define STEP(C0,C1,P0,P1,t,GK,GV,GL) do{ SBAR(); \
    const lds_cptr vp_=vp0+sl_prev; \
    VRD(0); SBAR(); float sacc=(P0[0]+P0[1]); \
    GAPA(C0=__builtin_amdgcn_mfma_f32_32x32x16_bf16(kf[0],qr[0],zc,0,0,0), P0[2],P0[3],P0[4],P0[5],     pw0[0]=PKW(P0,0), pw0[1]=PKW(P0,2), pw0); \
    VRD(4); SBAR(); GAPA(C1=__builtin_amdgcn_mfma_f32_32x32x16_bf16(kf[1],qr[0],zc,0,0,0), P0[6],P0[7],P0[8],P0[9],     pw0[2]=PKW(P0,4), pw0[3]=PKW(P0,6), pw0); \
    VRD(1); SBAR(); GAPA(C0=__builtin_amdgcn_mfma_f32_32x32x16_bf16(kf[2],qr[1],C0,0,0,0),   P0[10],P0[11],P0[12],P0[13], pw1[0]=PKW(P0,8), pw1[1]=PKW(P0,10), pw1); \
    VRD(5); SBAR(); GAPA(C1=__builtin_amdgcn_mfma_f32_32x32x16_bf16(kf[3],qr[1],C1,0,0,0),   P0[14],P0[15],P1[0],P1[1],   pw1[2]=PKW(P0,12),pw1[3]=PKW(P0,14), pw1); \
    VRD(2); SBAR(); GAPA(C0=__builtin_amdgcn_mfma_f32_32x32x16_bf16(kf[4],qr[2],C0,0,0,0),   P1[2],P1[3],P1[4],P1[5],     pw2[0]=PKW(P1,0), pw2[1]=PKW(P1,2), pw2); \
    VRD(6); SBAR(); GAPA(C1=__builtin_amdgcn_mfma_f32_32x32x16_bf16(kf[5],qr[2],C1,0,0,0),   P1[6],P1[7],P1[8],P1[9],     pw2[2]=PKW(P1,4), pw2[3]=PKW(P1,6), pw2); \
    VRD(3); SBAR(); GAPA(C0=__builtin_amdgcn_mfma_f32_32x32x16_bf16(kf[6],qr[3],C0,0,0,0),   P1[10],P1[11],P1[12],P1[13], pw3[0]=PKW(P1,8), pw3[1]=PKW(P1,10), pw3); \
    VRD(7); SBAR(); GAPA(C1=__builtin_amdgcn_mfma_f32_32x32x16_bf16(kf[7],qr[3],C1,0,0,0),   P1[14],P1[15],0.f,0.f,       pw3[2]=PKW(P1,12),pw3[3]=PKW(P1,14), pw3); \
    l_reg+=sacc; \
    if(GK){DMA_K((t)+3,sl_cur);} if(GV){DMA_V((t)+1,sl_next);} \
    CMASK(C0,C1,t); \
    { float a=MX3(C0[0],C0[1],C1[0]),b=MX3(C0[2],C0[3],C1[1]); a=MX3(a,C1[2],C1[3]); \
      _Pragma("unroll") for(int r=4;r<16;r+=4){a=MX3(a,C0[r],C0[r+1]);b=MX3(b,C0[r+2],C0[r+3]);a=MX3(a,C1[r],C1[r+1]);b=MX3(b,C1[r+2],C1[r+3]);} \
      float rm=__builtin_fmaxf(a,b); { auto rr=__builtin_amdgcn_permlane32_swap(__float_as_uint(rm),__float_as_uint(rm),false,false); rm=__builtin_fmaxf(__uint_as_float(rr[0]),__uint_as_float(rr[1])); } \
      rm-=mhat; resc=false; \
      if(__builtin_expect(__any(rm>(float)THRL),0)){ const float dl=__builtin_fmaxf(rm,0.f); mhat+=dl; \
        const float f=__builtin_amdgcn_exp2f(-dl); l_reg*=f; if(hi==0)wsf[r32]=f; resc=true; } } \
    SBAR(); \
    GAPB(o[0]=__builtin_amdgcn_mfma_f32_32x32x16_bf16(PAF(0),VFR(0),o[0],0,0,0), C0,0); \
    GAPB(o[1]=__builtin_amdgcn_mfma_f32_32x32x16_bf16(PAF(0),VFR(4),o[1],0,0,0), C0,4); \
    KRD(GL,0); GAPB(o[0]=__builtin_amdgcn_mfma_f32_32x32x16_bf16(PAF(1),VFR(1),o[0],0,0,0), C0,8); \
    KRD(GL,1); GAPB(o[1]=__builtin_amdgcn_mfma_f32_32x32x16_bf16(PAF(1),VFR(5),o[1],0,0,0), C0,12); \
    KRD(GL,2); GAPB(o[0]=__builtin_amdgcn_mfma_f32_32x32x16_bf16(PAF(2),VFR(2),o[0],0,0,0), C1,0); \
    KRD(GL,3); GAPB(o[1]=__builtin_amdgcn_mfma_f32_32x32x16_bf16(PAF(2),VFR(6),o[1],0,0,0), C1,4); \
    GAPB(o[0]=__builtin_amdgcn_mfma_f32_32x32x16_bf16(PAF(3),VFR(3),o[0],0,0,0), C1,8); \
    GAPB(o[1]=__builtin_amdgcn_mfma_f32_32x32x16_bf16(PAF(3),VFR(7),o[1],0,0,0), C1,12); \
    }while(0)
  int t=1;
  #undef CMASK
  #define CMASK(P0,P1,t) do{int jb_=(t); if(jb_<4)cmask(P0,P1,jb_,qrel,hi); else if(!((selmask>>((jb_-4)>>2))&1)){ _Pragma("unroll") for(int r_=0;r_<16;++r_){P0[r_]=-INFINITY;P1[r_]=-INFINITY;} } }while(0)
  #define ENDW(tt) do{ if((tt)+3<NT){WAIT_BAR(2);} else if((tt)+2<NT){WAIT_BAR(1);} else {WAIT_BAR(0);} }while(0)
  for(;t+1<NT;t+=2){
    STEP(pB0,pB1,pA0,pA1,t,(t+3<NT),(t+1<NT),(t+1<NT));       ENDW(t);   RESC(); ROT();
    STEP(pA0,pA1,pB0,pB1,t+1,(t+4<NT),(t+2<NT),(t+2<NT));     ENDW(t+1); RESC(); ROT();
  }
  STEP(pB0,pB1,pA0,pA1,NT-1,false,false,false); RESC();
  { float sacc=pB0[0]+pB0[1]; _Pragma("unroll") for(int r=2;r<16;++r)sacc+=pB0[r]; _Pragma("unroll") for(int r=0;r<16;++r)sacc+=pB1[r]; l_reg+=sacc;
    pw0=(u32x4){PKW(pB0,0),PKW(pB0,2),PKW(pB0,4),PKW(pB0,6)};pw1=(u32x4){PKW(pB0,8),PKW(pB0,10),PKW(pB0,12),PKW(pB0,14)};pw2=(u32x4){PKW(pB1,0),PKW(pB1,2),PKW(pB1,4),PKW(pB1,6)};pw3=(u32x4){PKW(pB1,8),PKW(pB1,10),PKW(pB1,12),PKW(pB1,14)};
    SBAR(); pv(o,vb0+sl_cur,PAF(0),PAF(1),PAF(2),PAF(3)); }
  #undef PKW
  #undef PAF
  #undef VFR
  #undef PIN
  #undef MX3
  #undef GAPA
  #undef GAPB
  #undef EX
  #undef VRD
  #undef KRD
  #undef STEP
  #undef ENDW
  {auto rr=__builtin_amdgcn_permlane32_swap(__float_as_uint(l_reg),__float_as_uint(l_reg),false,false);l_reg=__uint_as_float(rr[0])+__uint_as_float(rr[1]);}
  if(hi==0)wsf[32+r32]=l_reg;asm volatile("s_waitcnt lgkmcnt(0)":::"memory");
  float rli[16];
  #pragma unroll
  for(int r=0;r<16;++r)rli[r]=__builtin_amdgcn_rcpf(wsf[32+crow(r,hi)]);
  bf16*Ow=O+(rowbase+q0+wid*QBLK)*DM+h*D;
  { bf16*stg=(bf16*)(shm+LDS_OST)+wid*2048;
    #pragma unroll
    for(int r=0;r<16;++r){const int orow=crow(r,hi);
      #pragma unroll
      for(int d0=0;d0<2;++d0)stg[orow*64+d0*32+r32]=__float2bfloat16(o[d0][r]*rli[r]);}
    asm volatile("s_waitcnt lgkmcnt(0)":::"memory");
    #pragma unroll
    for(int i=0;i<4;++i){const int row=i*8+(lane>>3),ch=lane&7; const u32x4 v=*(const u32x4*)(stg+row*64+ch*8); ATTN_STORE16(Ow+(long)row*DM+ch*8,v);} }
  asm volatile("s_waitcnt lgkmcnt(0)\n\ts_barrier":::"memory");
  #undef DMA_K
  #undef PHYS
  #undef DMA_V
  #undef CMASK
  #undef START
  #undef RESC
  #undef ROT
}
constexpr int ATTN_LDS_BYTES=LDS_BYTES;
struct AttnTensors { const bf16* Q; const bf16* K; const bf16* V; bf16* O; const float* KM; };
struct AttnUnit { int bh; int qb; };
struct StaticOrder {
  int vcu,G;
  __device__ __forceinline__ explicit StaticOrder(int grid,int block):vcu((grid%8==0)?(block%8)*(grid/8)+block/8:block),G(grid){}
  __device__ __forceinline__ bool next(int i,AttnUnit&u)const{ const int idx=i*G+vcu; if(idx>=1024)return false; const int v=idx&255,j=idx>>8; u.bh=v>>1;
    const int s=(v&1); u.qb=(j==0)?s:(j==1)?7-s:(j==2)?3-s:4+s; return true; }
  __device__ __forceinline__ void a_ready(const AttnUnit&)const{}
  __device__ __forceinline__ void done(const AttnUnit&)const{}
};
template<class Sched,int THRL=8> __device__ __forceinline__ void attn_phase(char*lds,const AttnTensors&T,const Sched&S){
  AttnUnit u;
  for(int i=0;S.next(i,u);++i){ S.a_ready(u); attn_unit<THRL>(u.bh/NHEAD,u.bh%NHEAD,u.qb,T.Q,T.K,T.V,T.O,T.KM,lds); S.done(u); }
}
#undef SBAR
#undef WAIT_BAR
}
struct Args { const float* in[29]; float* out; unsigned char* ws; int ph_lo, ph_hi, li, pad; };
typedef const __attribute__((address_space(4))) Args* ArgsP;
__device__ __forceinline__ ArgsP fresh_args() { ArgsP p = (ArgsP)__builtin_amdgcn_kernarg_segment_ptr(); asm volatile("" : "+s"(p)); return p; }

struct Frame {
    LAS unsigned char* lds;
    volatile LAS unsigned* MISC;
    gu32* ctl;
    int tid, lane, wave, vcu, G;
};

__device__ __forceinline__ void conv_item(const float* W, int N, bf16_t* WT, int Kd, int dst_row0, int k0, int n0, LAS float* scr, int lane) {
#pragma unroll 8
    for (int i = 0; i < 32; ++i) { const int kk = 2 * i + (lane >> 5); scr[kk * 33 + (lane & 31)] = W[(size_t)(k0 + kk) * N + n0 + (lane & 31)]; }
    LDS_WAIT(); asm volatile("" ::: "memory");
    const int c = lane & 7;
#pragma unroll
    for (int j = 0; j < 4; ++j) { const int n = (lane >> 3) + 8 * j; const LAS float* s = scr + (8 * c) * 33 + n;
        u32x4 o; o.x = pk2(s[0 * 33], s[1 * 33]); o.y = pk2(s[2 * 33], s[3 * 33]); o.z = pk2(s[4 * 33], s[5 * 33]); o.w = pk2(s[6 * 33], s[7 * 33]);
        *(u32x4*)(WT + (size_t)(dst_row0 + n) * Kd + k0 + 8 * c) = o; }
    LDS_WAIT(); asm volatile("" ::: "memory");
}
__device__ __forceinline__ void conv_moe_layer(const Frame& F, ArgsP a, int layer, bf16_t* GU, bf16_t* DN, LAS float* scr) {
    const int gw = F.vcu * NWAVES + F.wave, NGW = F.G * NWAVES;
    constexpr int PER_E = 384, NIT = 65 * PER_E;
    for (int it = gw; it < NIT; it += NGW) {
        const int e = it / PER_E, r = it % PER_E, which = r >> 7, q = r & 127;
        const float* src;
        if (e < 64) src = a->in[22 + which] + (size_t)(layer * 64 + e) * (1024 * 256);
        else src = a->in[25 + which] + (size_t)layer * (1024 * 256);
        if (which < 2) { const int kb = q >> 3, nb = q & 7, n0 = nb * 32;
            conv_item(src, 256, GU, 1024, e * 512 + (n0 >> 7) * 256 + which * 128 + (n0 & 127), kb * 64, n0, scr, F.lane);
        } else { const int kb = q >> 5, nb = q & 31, n0 = nb * 32;
            conv_item(src, 1024, DN, 256, e * 1024 + n0, kb * 64, n0, scr, F.lane); }
    }
}
__device__ __forceinline__ void conv_dense(const Frame& F, const float* W, int K, int N, bf16_t* WT, LAS float* scr) {
    const int gw = F.vcu * NWAVES + F.wave, NGW = F.G * NWAVES;
    const int nblk = N / 32, nit = (K / 64) * nblk;
    for (int it = gw; it < nit; it += NGW) { const int kb = it / nblk, nb = it % nblk; conv_item(W, N, WT, K, nb * 32, kb * 64, nb * 32, scr, F.lane); }
}

__device__ __forceinline__ void row_load(const float* row, int lane, float (&v)[16]) {
#pragma unroll
    for (int jj = 0; jj < 2; ++jj) { const f32x4 a = *(const f32x4*)(row + 8 * lane + 512 * jj), b = *(const f32x4*)(row + 8 * lane + 512 * jj + 4);
#pragma unroll
        for (int j = 0; j < 4; ++j) { v[8 * jj + j] = a[j]; v[8 * jj + 4 + j] = b[j]; } }
}
__device__ __forceinline__ void row_store(float* row, int lane, const float (&v)[16]) {
#pragma unroll
    for (int jj = 0; jj < 2; ++jj) { *(f32x4*)(row + 8 * lane + 512 * jj) = (f32x4){v[8 * jj], v[8 * jj + 1], v[8 * jj + 2], v[8 * jj + 3]}; *(f32x4*)(row + 8 * lane + 512 * jj + 4) = (f32x4){v[8 * jj + 4], v[8 * jj + 5], v[8 * jj + 6], v[8 * jj + 7]}; }
}
__device__ __forceinline__ float row_rstd(const float (&v)[16]) {
    float s = 0.f;
#pragma unroll
    for (int j = 0; j < 16; ++j) s += v[j] * v[j];
    return rsqrtf(wave_sum(s) * (1.0f / D) + RMS_EPS);
}
__device__ __forceinline__ void row_mod(const float (&v)[16], float rstd, const float* g, const float* shift, const float* scale, int lane, float (&h)[16]) {
    float gg[16], sh[16], sc[16];
    row_load(g, lane, gg); row_load(shift, lane, sh); row_load(scale, lane, sc);
#pragma unroll
    for (int j = 0; j < 16; ++j) h[j] = (v[j] * rstd * gg[j]) * (1.0f + sc[j]) + sh[j];
}
__device__ __forceinline__ void row_store_bf16(bf16_t* row, int lane, const float (&h)[16]) {
#pragma unroll
    for (int jj = 0; jj < 2; ++jj) { u32x4 w; w.x = pk2(h[8 * jj], h[8 * jj + 1]); w.y = pk2(h[8 * jj + 2], h[8 * jj + 3]); w.z = pk2(h[8 * jj + 4], h[8 * jj + 5]); w.w = pk2(h[8 * jj + 6], h[8 * jj + 7]);
        *(u32x4*)(row + 8 * lane + 512 * jj) = w; }
}
__device__ __forceinline__ void row_add_y(float (&v)[16], const bf16_t* y, const float* gate, int lane) {
    float s[16];
#pragma unroll
    for (int j = 0; j < 16; ++j) s[j] = 0.f;
#pragma unroll
    for (int k = 0; k < TOPK; ++k)
#pragma unroll
        for (int jj = 0; jj < 2; ++jj) { const u32x4 w = *(const u32x4*)(y + (size_t)k * D + 8 * lane + 512 * jj);
            s[8 * jj + 0] += bf_lo(w.x); s[8 * jj + 1] += bf_hi(w.x); s[8 * jj + 2] += bf_lo(w.y); s[8 * jj + 3] += bf_hi(w.y);
            s[8 * jj + 4] += bf_lo(w.z); s[8 * jj + 5] += bf_hi(w.z); s[8 * jj + 6] += bf_lo(w.w); s[8 * jj + 7] += bf_hi(w.w); }
    float gg[16]; row_load(gate, lane, gg);
#pragma unroll
    for (int j = 0; j < 16; ++j) v[j] += gg[j] * s[j];
}

__device__ __forceinline__ void phase_p0(const Frame& F, ArgsP a) {
    unsigned char* ws = a->ws;
    if ((int)blockIdx.x < 224) {
        LAS float* sc = (LAS float*)F.lds;
        LAS float* red = (LAS float*)(F.lds + 32768);
        const float* c = a->in[1];
        for (int i = F.tid; i < 8 * 1024; i += NTHREADS) sc[i] = silu_f(c[i]);
        __syncthreads();
        const int cg = blockIdx.x;
        const float* W; const float* bias; float* out; int N, n0;
        if (cg < 96) { W = a->in[2]; bias = a->in[3]; out = (float*)(ws + WS_MOD); N = 6144; n0 = cg * 64; }
        else if (cg < 192) { W = a->in[2] + (size_t)1024 * 6144; bias = a->in[3] + 6144; out = (float*)(ws + WS_MOD) + MOD_L; N = 6144; n0 = (cg - 96) * 64; }
        else { W = a->in[14]; bias = a->in[15]; out = (float*)(ws + WS_MOD) + 2 * MOD_L; N = 2048; n0 = (cg - 192) * 64; }
        float acc[8];
#pragma unroll
        for (int b = 0; b < 8; ++b) acc[b] = 0.f;
        const int k0 = F.wave * 128;
#pragma unroll 4
        for (int kk = 0; kk < 128; kk += 4) {
            float w[4];
#pragma unroll
            for (int i = 0; i < 4; ++i) w[i] = W[(size_t)(k0 + kk + i) * N + n0 + F.lane];
#pragma unroll
            for (int b = 0; b < 8; ++b) { const f32x4 s = *(const LAS f32x4*)(sc + b * 1024 + k0 + kk); acc[b] += s[0] * w[0]; acc[b] += s[1] * w[1]; acc[b] += s[2] * w[2]; acc[b] += s[3] * w[3]; }
        }
#pragma unroll
        for (int b = 0; b < 8; ++b) red[(F.wave * 8 + b) * 64 + F.lane] = acc[b];
        __syncthreads();
        { const int b = F.tid >> 6, l = F.tid & 63; float s = 0.f;
#pragma unroll
            for (int w = 0; w < 8; ++w) s += red[(w * 8 + b) * 64 + l];
            out[(size_t)b * N + n0 + l] = s + bias[n0 + l]; }
        __syncthreads();
    }
    LAS float* scr = (LAS float*)(F.lds + F.wave * 16384);
    conv_dense(F, a->in[6], 1024, 4096, (bf16_t*)(ws + WS_WIN_T), scr);
    conv_dense(F, a->in[12], 2048, 1024, (bf16_t*)(ws + WS_WOUT_T), scr);
    conv_dense(F, a->in[18], 1024, 1024, (bf16_t*)(ws + WS_WQKV_T), scr);
    conv_dense(F, a->in[16], 1024, 1024, (bf16_t*)(ws + WS_WQKV_T) + (size_t)1024 * 1024, scr);
    conv_dense(F, a->in[17], 1024, 1024, (bf16_t*)(ws + WS_WQKV_T) + (size_t)2048 * 1024, scr);
    conv_dense(F, a->in[19], 1024, 1024, (bf16_t*)(ws + WS_WO_T), scr);
    conv_moe_layer(F, a, 0, (bf16_t*)(ws + WS_GU), (bf16_t*)(ws + WS_DN), scr);
    { const float* wsp = a->in[10]; bf16_t* o = (bf16_t*)(ws + WS_WSP);
      for (int i = blockIdx.x * NTHREADS + F.tid; i < 8 * 128 * 128; i += F.G * NTHREADS) { const int t = (i >> 7) & 127, s = i & 127; o[i] = (bf16_t)(s <= t ? f2bf(wsp[i]) : 0u); } }
}

__device__ __forceinline__ void phase_p1(const Frame& F, ArgsP a) {
    const int gw = blockIdx.x * NWAVES + F.wave, NGW = F.G * NWAVES;
    const float* mod = (const float*)(a->ws + WS_MOD);
    bf16_t* hA = (bf16_t*)(a->ws + WS_SCR);
    for (int m = gw; m < T; m += NGW) {
        const int b = m / SEQ; float v[16], h[16];
        row_load(a->in[0] + (size_t)m * D, F.lane, v);
        const float rstd = row_rstd(v);
        row_mod(v, rstd, a->in[4], mod + (size_t)b * 6144, mod + (size_t)b * 6144 + 1024, F.lane, h);
        row_store_bf16(hA + (size_t)m * D, F.lane, h);
    }
}

__device__ __forceinline__ void phase_p3(const Frame& F, ArgsP a) {
    bf16_t* U = (bf16_t*)(a->ws + WS_SCR + 64 * MiB); const bf16_t* VT = (const bf16_t*)(a->ws + WS_SCR + 128 * MiB);
    const bf16_t* Wsp = (const bf16_t*)(a->ws + WS_WSP); const float* vpart = (const float*)(a->ws + WS_VPART);
    const float* lng = a->in[8]; const float* lnb = a->in[9]; const float* bsp = a->in[11];
    LAS float* mu = (LAS float*)F.lds; LAS float* rs = mu + 128;
    const int fr = F.lane & 15, fq = F.lane >> 4;
    for (int item = blockIdx.x; item < 256; item += F.G) {
        const int chunk = item >> 1, g0 = (item & 1) * 4;
        __syncthreads();
        if (F.tid < 128) { const float* p = vpart + (size_t)(chunk * 128 + F.tid) * 64; float s1 = 0.f, s2 = 0.f;
            for (int j = 0; j < 32; ++j) { s1 += p[2 * j]; s2 += p[2 * j + 1]; }
            const float mean = s1 * (1.0f / AW), var = s2 * (1.0f / AW) - mean * mean; mu[F.tid] = mean; rs[F.tid] = rsqrtf(var + LN_EPS); }
        __syncthreads();
        for (int gi = 0; gi < 4; ++gi) {
            const int g = g0 + gi;
            f32x4 acc[2][8];
#pragma unroll
            for (int dt = 0; dt < 2; ++dt)
#pragma unroll
                for (int tt = 0; tt < 8; ++tt) acc[dt][tt] = (f32x4){0.f, 0.f, 0.f, 0.f};
            bf16x8 af[2][4];
#pragma unroll
            for (int dt = 0; dt < 2; ++dt) {
                const int col = g * 256 + 32 * F.wave + 16 * dt + fr; const float lg = lng[col], lb = lnb[col];
#pragma unroll
                for (int ks = 0; ks < 4; ++ks) {
                    const int s0 = 32 * ks + 8 * fq;
                    const u32x4 raw = *(const u32x4*)(VT + ((size_t)chunk * AW + col) * 128 + s0);
                    const f32x4 m0 = *(const LAS f32x4*)(mu + s0), m1 = *(const LAS f32x4*)(mu + s0 + 4), r0 = *(const LAS f32x4*)(rs + s0), r1 = *(const LAS f32x4*)(rs + s0 + 4);
                    float x[8] = {bf_lo(raw.x), bf_hi(raw.x), bf_lo(raw.y), bf_hi(raw.y), bf_lo(raw.z), bf_hi(raw.z), bf_lo(raw.w), bf_hi(raw.w)};
#pragma unroll
                    for (int j = 0; j < 4; ++j) { x[j] = (x[j] - m0[j]) * r0[j] * lg + lb; x[4 + j] = (x[4 + j] - m1[j]) * r1[j] * lg + lb; }
                    u32x4 o; o.x = pk2(x[0], x[1]); o.y = pk2(x[2], x[3]); o.z = pk2(x[4], x[5]); o.w = pk2(x[6], x[7]);
                    af[dt][ks] = __builtin_bit_cast(bf16x8, o);
                }
            }
#pragma unroll
            for (int tt = 0; tt < 8; ++tt)
#pragma unroll
                for (int ks = 0; ks < 4; ++ks) if (2 * ks <= tt) {
                    const bf16x8 bw = *(const bf16x8*)(Wsp + ((size_t)g * 128 + 16 * tt + fr) * 128 + 32 * ks + 8 * fq);
#pragma unroll
                    for (int dt = 0; dt < 2; ++dt) acc[dt][tt] = __builtin_amdgcn_mfma_f32_16x16x32_bf16(af[dt][ks], bw, acc[dt][tt], 0, 0, 0);
                }
#pragma unroll
            for (int tt = 0; tt < 8; ++tt) {
                const int t = 16 * tt + fr; const float bs = bsp[g * 128 + t];
#pragma unroll
                for (int dt = 0; dt < 2; ++dt) {
                    bf16_t* up = U + (size_t)(chunk * 128 + t) * AW + g * 256 + 32 * F.wave + 16 * dt + 4 * fq;
                    const u32x2 uu = *(const u32x2*)up; const f32x4 sv = acc[dt][tt] + bs;
                    u32x2 o; o.x = pk2(bf_lo(uu.x) * sv[0], bf_hi(uu.x) * sv[1]); o.y = pk2(bf_lo(uu.y) * sv[2], bf_hi(uu.y) * sv[3]);
                    *(u32x2*)up = o;
                }
            }
        }
    }
}

__device__ __forceinline__ void phase_router(const Frame& F, ArgsP a, int layer) {
    const float* X = a->out; bf16_t* hA = (bf16_t*)(a->ws + WS_SCR);
    const float* mod = (const float*)(a->ws + WS_MOD) + (size_t)layer * MOD_L;
    const float* nw = a->in[5] + layer * D; const float* Wr = a->in[20] + (size_t)layer * D * NE; const float* eb = a->in[21] + layer * NE;
    int* toklist = (int*)(a->ws + WS_TOKLIST); float* wlist = (float*)(a->ws + WS_WLIST);
    unsigned* cnt = (unsigned*)(a->ws + WS_CTL) + CW_CNT + layer * 64;
    LAS float* xs = (LAS float*)F.lds + F.wave * 4096;
    LAS int* sel_e = (LAS int*)(F.lds + LDS_AUX); LAS float* sel_w = (LAS float*)(sel_e + 512); LAS int* sel_li = (LAS int*)(sel_w + 512);
    LAS int* hist = sel_li + 512; LAS int* gbase = hist + 64;
    for (int grp = blockIdx.x; grp < T / 64; grp += F.G) {
        __syncthreads();
        if (F.tid < 64) hist[F.tid] = 0;
        __syncthreads();
        for (int rd = 0; rd < 2; ++rd) {
            const int tl0 = rd * 32 + F.wave * 4;
#pragma unroll 1
            for (int j = 0; j < 4; ++j) {
                const int t = grp * 64 + tl0 + j, b = t / SEQ; float v[16], h[16];
                row_load(X + (size_t)t * D, F.lane, v);
                const float rstd = row_rstd(v);
                row_mod(v, rstd, nw, mod + (size_t)b * 6144 + 3072, mod + (size_t)b * 6144 + 4096, F.lane, h);
                row_store_bf16(hA + (size_t)t * D, F.lane, h);
#pragma unroll
                for (int jj = 0; jj < 2; ++jj) { *(LAS f32x4*)(xs + j * 1024 + 8 * F.lane + 512 * jj) = (f32x4){h[8 * jj], h[8 * jj + 1], h[8 * jj + 2], h[8 * jj + 3]};
                    *(LAS f32x4*)(xs + j * 1024 + 8 * F.lane + 512 * jj + 4) = (f32x4){h[8 * jj + 4], h[8 * jj + 5], h[8 * jj + 6], h[8 * jj + 7]}; }
            }
            LDS_WAIT(); asm volatile("" ::: "memory");
            float lg[4] = {0.f, 0.f, 0.f, 0.f};
#pragma unroll 2
            for (int d0 = 0; d0 < D; d0 += 4) {
                float w[4];
#pragma unroll
                for (int i = 0; i < 4; ++i) w[i] = Wr[(size_t)(d0 + i) * NE + F.lane];
#pragma unroll
                for (int j = 0; j < 4; ++j) { const f32x4 xv = *(const LAS f32x4*)(xs + j * 1024 + d0); lg[j] += xv[0] * w[0]; lg[j] += xv[1] * w[1]; lg[j] += xv[2] * w[2]; lg[j] += xv[3] * w[3]; }
            }
            const float bias = eb[F.lane];
#pragma unroll
            for (int j = 0; j < 4; ++j) {
                const float score = 1.0f / (1.0f + __expf(-lg[j])), choice = score + bias;
                float m1 = choice; m1 = fmaxf(m1, __shfl_xor(m1, 1)); m1 = fmaxf(m1, __shfl_xor(m1, 2)); m1 = fmaxf(m1, __shfl_xor(m1, 4));
                int idx = (choice == m1) ? (F.lane & 7) : 8; idx = min(idx, __shfl_xor(idx, 1)); idx = min(idx, __shfl_xor(idx, 2)); idx = min(idx, __shfl_xor(idx, 4));
                float m2 = ((F.lane & 7) == idx) ? -INFINITY : choice; m2 = fmaxf(m2, __shfl_xor(m2, 1)); m2 = fmaxf(m2, __shfl_xor(m2, 2)); m2 = fmaxf(m2, __shfl_xor(m2, 4));
                const float gs = m1 + m2; const int g = F.lane >> 3;
                int grank = 0;
#pragma unroll
                for (int g2 = 0; g2 < 8; ++g2) { const float o = __shfl(gs, g2 * 8); grank += ((o > gs) || (o == gs && g2 < g)) ? 1 : 0; }
                const float cm = (grank < 4) ? choice : -1e30f;
                int rank = 0;
#pragma unroll
                for (int e2 = 0; e2 < 64; ++e2) { const float o = __shfl(cm, e2); rank += ((o > cm) || (o == cm && e2 < F.lane)) ? 1 : 0; }
                const bool sel = rank < TOPK;
                const float wsum = wave_sum(sel ? score : 0.f);
                const float w = score / wsum * ROUTED_SCALE;
                const unsigned long long bal = __ballot(sel);
                if (sel) { const int k = __popcll(bal & ((1ull << F.lane) - 1ull)); const int tl = tl0 + j;
                    sel_e[tl * 8 + k] = F.lane; sel_w[tl * 8 + k] = w; sel_li[tl * 8 + k] = __hip_atomic_fetch_add(&hist[F.lane], 1, __ATOMIC_RELAXED, __HIP_MEMORY_SCOPE_WORKGROUP); }
            }
        }
        __syncthreads();
        if (F.tid < 64) gbase[F.tid] = (int)__hip_atomic_fetch_add(cnt + F.tid, (unsigned)hist[F.tid], RLX_AGENT);
        __syncthreads();
        { const int p = F.tid, e = sel_e[p], pos = gbase[e] + sel_li[p];
          toklist[(size_t)e * CAP + pos] = (grp * 64 + (p >> 3)) * 8 + (p & 7); wlist[(size_t)e * CAP + pos] = sel_w[p]; }
    }
}

__device__ __forceinline__ void moe_tables(const Frame& F, ArgsP a, int layer, LAS int* cntl, LAS int* tb) {
    const unsigned* cnt = (const unsigned*)(a->ws + WS_CTL) + CW_CNT + layer * 64;
    __syncthreads();
    if (F.tid < 64) cntl[F.tid] = (int)__hip_atomic_load(cnt + F.tid, RLX_AGENT);
    __syncthreads();
    if (F.tid == 0) { int s = 0; for (int e = 0; e < 64; ++e) { tb[e] = s; s += (cntl[e] + 255) >> 8; } tb[64] = s; tb[65] = s + T / 256; }
    __syncthreads();
}

__device__ __forceinline__ void phase_p8(const Frame& F, ArgsP a) {
    const int gw = blockIdx.x * NWAVES + F.wave, NGW = F.G * NWAVES;
    const float* mod0 = (const float*)(a->ws + WS_MOD); const float* mod1 = mod0 + MOD_L; const float* modkv = mod0 + 2 * MOD_L;
    float* X = a->out; const bf16_t* Y = (const bf16_t*)(a->ws + WS_SCR); bf16_t* hB = (bf16_t*)(a->ws + WS_H);
    for (int m = gw; m < T; m += NGW) {
        const int b = m / SEQ; float v[16], h[16];
        row_load(X + (size_t)m * D, F.lane, v);
        row_add_y(v, Y + (size_t)m * TOPK * D, mod0 + (size_t)b * 6144 + 5120, F.lane);
        row_store(X + (size_t)m * D, F.lane, v);
        const float rstd = row_rstd(v);
        row_mod(v, rstd, a->in[4] + D, mod1 + (size_t)b * 6144, mod1 + (size_t)b * 6144 + 1024, F.lane, h);
        row_store_bf16(hB + (size_t)m * D, F.lane, h);
        row_mod(v, rstd, a->in[13], modkv + (size_t)b * 2048, modkv + (size_t)b * 2048 + 1024, F.lane, h);
        row_store_bf16(hB + (size_t)(T + m) * D, F.lane, h);
    }
    LAS float* scr = (LAS float*)(F.lds + F.wave * 16384);
    conv_moe_layer(F, a, 1, (bf16_t*)(a->ws + WS_GU), (bf16_t*)(a->ws + WS_DN), scr);
}

__device__ __forceinline__ void phase_final(const Frame& F, ArgsP a) {
    const int gw = blockIdx.x * NWAVES + F.wave, NGW = F.G * NWAVES;
    const float* mod1 = (const float*)(a->ws + WS_MOD) + MOD_L;
    float* X = a->out; const bf16_t* Y = (const bf16_t*)(a->ws + WS_SCR);
    for (int m = gw; m < T; m += NGW) {
        const int b = m / SEQ; float v[16], g[16];
        row_load(X + (size_t)m * D, F.lane, v);
        row_add_y(v, Y + (size_t)m * TOPK * D, mod1 + (size_t)b * 6144 + 5120, F.lane);
        const float rstd = row_rstd(v);
        row_load(a->in[28], F.lane, g);
#pragma unroll
        for (int j = 0; j < 16; ++j) v[j] = v[j] * rstd * g[j];
        row_store(X + (size_t)m * D, F.lane, v);
    }
}
#ifndef MK_N_LAUNCHES
#define MK_N_LAUNCHES 1
#endif
constexpr int N_PHASES = 16;
constexpr int N_LAUNCHES = MK_N_LAUNCHES;

__global__ void __launch_bounds__(NTHREADS, 2) yoco_fwd(Args args) {
    extern __shared__ __attribute__((aligned(16))) unsigned char lds[];
    Frame F;
    F.lds = (LAS unsigned char*)lds;
    F.MISC = (volatile LAS unsigned*)(F.lds + MISC_OFF);
    F.tid = threadIdx.x; F.lane = F.tid & 63; F.wave = __builtin_amdgcn_readfirstlane(F.tid >> 6);
    F.G = gridDim.x; { const int bx = blockIdx.x; F.vcu = (F.G % 8 == 0) ? (bx % 8) * (F.G / 8) + bx / 8 : bx; }
    F.ctl = (gu32*)(args.ws + WS_CTL);
    for (int u = F.tid; u < (LDS_BYTES - LDSCTL_OFF) / 4; u += NTHREADS) ((LAS unsigned*)(F.lds + LDSCTL_OFF))[u] = 0u;
    __syncthreads();
    XcdBarrier bar; bar.bar = (unsigned*)(F.ctl + CW_BAR); bar.x = 0; bar.st = nullptr;
    if (N_LAUNCHES == 1) bar = xcd_barrier_post((unsigned*)(F.ctl + CW_BAR), F.MISC + 8);
#define GRID_BAR() do { if (N_LAUNCHES == 1) xcd_barrier(bar); } while (0)
    const int lo = args.ph_lo, hi = args.ph_hi;
#ifndef PH_MASK
#define PH_MASK 0xFFFFFFFFu
#endif
#define PHON(k) ((PH_MASK >> (k)) & 1u)
#define IN(k) (lo <= (k) && (k) < hi && PHON((k) >= 12 ? (k) - 7 : (k)))
#define SEAM(k) do { if (IN(k) && IN((k) + 1)) GRID_BAR(); } while (0)
    LAS int* cntl = (LAS int*)(F.lds + LDS_AUX + 8192); LAS int* tb = cntl + 64;
    const int c = (int)blockIdx.x;

    if (IN(0)) { phase_p0(F, fresh_args()); } SEAM(0);
    if (IN(1)) { phase_p1(F, fresh_args()); } SEAM(1);
    if (IN(2)) {
        ArgsP a = fresh_args(); unsigned char* ws = a->ws;
        DenseSched S; S.init(T, 4096, F.G, c);
        EpiGemm1 E{(bf16_t*)(ws + WS_SCR + 64 * MiB), (bf16_t*)(ws + WS_SCR + 128 * MiB), (float*)(ws + WS_VPART), a->in[7]};
        gemm_ref((const bf16_t*)(ws + WS_SCR), (const bf16_t*)(ws + WS_WIN_T), 1024, S, E);
    } SEAM(2);
    if (IN(3)) { phase_p3(F, fresh_args()); } SEAM(3);
    if (IN(4)) {
        ArgsP a = fresh_args(); unsigned char* ws = a->ws;
        DenseSched S; S.init(T, 1024, F.G, c);
        EpiResid E{a->in[0], a->out, (const float*)(ws + WS_MOD) + 2048, 6144};
        gemm_ref((const bf16_t*)(ws + WS_SCR + 64 * MiB), (const bf16_t*)(ws + WS_WOUT_T), 2048, S, E);
    } SEAM(4);
#define MOE_PHASES(layer, pb) \
    if (IN(pb)) { phase_router(F, fresh_args(), layer); } SEAM(pb); \
    if (IN(pb + 1)) { ArgsP a = fresh_args(); unsigned char* ws = a->ws; \
        moe_tables(F, a, layer, cntl, tb); \
        MoeSched<true> S; S.init(tb, cntl, (const int*)(ws + WS_TOKLIST), F.G, F.vcu); \
        EpiGateUp E{(bf16_t*)(ws + WS_H)}; \
        gemm_ref((const bf16_t*)(ws + WS_SCR), (const bf16_t*)(ws + WS_GU), 1024, S, E); \
    } SEAM(pb + 1); \
    if (IN(pb + 2)) { ArgsP a = fresh_args(); unsigned char* ws = a->ws; \
        moe_tables(F, a, layer, cntl, tb); \
        MoeSched<false> S; S.init(tb, cntl, (const int*)(ws + WS_TOKLIST), F.G, F.vcu); \
        EpiDown E{(bf16_t*)(ws + WS_SCR), a->out, (const int*)(ws + WS_TOKLIST), (const float*)(ws + WS_WLIST), (const float*)(ws + WS_MOD) + (size_t)layer * MOD_L + 5120, 6144, tb}; \
        gemm_ref((const bf16_t*)(ws + WS_H), (const bf16_t*)(ws + WS_DN), 256, S, E); \
    } SEAM(pb + 2);
    MOE_PHASES(0, 5)
    if (IN(8)) { phase_p8(F, fresh_args()); } SEAM(8);
    if (IN(9)) {
        ArgsP a = fresh_args(); unsigned char* ws = a->ws;
        DenseSched S; S.init(T, 3072, F.G, c, 4, T);
        EpiQKV E{(bf16_t*)(ws + WS_SCR + 64 * MiB), (float*)(ws + WS_CTL + CTL_KMEAN)};
        gemm_ref((const bf16_t*)(ws + WS_H), (const bf16_t*)(ws + WS_WQKV_T), 1024, S, E);
    } SEAM(9);
    if (IN(10)) {
        ArgsP a = fresh_args(); unsigned char* ws = a->ws;
        const attn_body::AttnTensors AT{(const attn_body::bf16*)(ws + WS_SCR + 64 * MiB), (const attn_body::bf16*)(ws + WS_SCR + 96 * MiB), (const attn_body::bf16*)(ws + WS_SCR + 128 * MiB),
                                        (attn_body::bf16*)(ws + WS_SCR + 64 * MiB), (const float*)(ws + WS_CTL + CTL_KMEAN)};
        const attn_body::StaticOrder S((int)F.G, (int)blockIdx.x);
        attn_body::attn_phase<attn_body::StaticOrder>((char*)lds, AT, S);
    } SEAM(10);
    if (IN(11)) {
        ArgsP a = fresh_args(); unsigned char* ws = a->ws;
        DenseSched S; S.init(T, 1024, F.G, c);
        EpiResid E{a->out, a->out, (const float*)(ws + WS_MOD) + MOD_L + 2048, 6144};
        gemm_ref((const bf16_t*)(ws + WS_SCR + 64 * MiB), (const bf16_t*)(ws + WS_WO_T), 1024, S, E);
    } SEAM(11);
    MOE_PHASES(1, 12)
    if (IN(15)) { phase_final(F, fresh_args()); }
#undef IN
#undef SEAM
#undef GRID_BAR
}

extern "C" void kernel_launch(void* const* d_in, const int* in_sizes, int n_in, void* d_out, int out_size, void* d_ws, size_t ws_size, hipStream_t stream) {
    static int grid = 0;
    if (grid == 0) {
        if (n_in != 29 || in_sizes[0] != T * D || out_size != T * D || ws_size < WS_END) {
            fprintf(stderr, "kernel_launch: shape/workspace mismatch: n_in %d in0 %d out %d ws %zu (need %zu); nothing launched\n", n_in, n_in > 0 ? in_sizes[0] : -1, out_size, ws_size, (size_t)WS_END); grid = -1; return; }
        int dev = 0, cus = 0, per_cu = 0;
        if (hipGetDevice(&dev) != hipSuccess || hipDeviceGetAttribute(&cus, hipDeviceAttributeMultiprocessorCount, dev) != hipSuccess) { grid = -1; return; }
        if (hipFuncSetAttribute((const void*)yoco_fwd, hipFuncAttributeMaxDynamicSharedMemorySize, LDS_BYTES) != hipSuccess) { fprintf(stderr, "kernel_launch: hipFuncSetAttribute failed\n"); grid = -1; return; }
        if (hipOccupancyMaxActiveBlocksPerMultiprocessor(&per_cu, (const void*)yoco_fwd, NTHREADS, LDS_BYTES) != hipSuccess || per_cu < 1)
            fprintf(stderr, "kernel_launch: note: occupancy query reports %d workgroups per CU\n", per_cu);
        (void)hipGetLastError();
        grid = cus;
    }
    if (grid < 0) return;
    if (hipMemsetAsync((char*)d_ws + WS_CTL, 0, CTL_ZERO_BYTES, stream) != hipSuccess) return;
    Args a{};
    for (int i = 0; i < 29; ++i) a.in[i] = (const float*)d_in[i];
    a.out = (float*)d_out; a.ws = (unsigned char*)d_ws;
    for (int li = 0; li < N_LAUNCHES; ++li) {
        a.ph_lo = (N_LAUNCHES == 1) ? 0 : li; a.ph_hi = (N_LAUNCHES == 1) ? N_PHASES : li + 1; a.li = li;
        hipLaunchKernelGGL(yoco_fwd, dim3(grid), dim3(NTHREADS), LDS_BYTES, stream, a);
    }
}
```

```cpp
#include <hip/hip_runtime.h>
#include <hip/hip_bf16.h>
#include <cstdio>
#include <cstdint>
#include <cmath>

#define GAS __attribute__((address_space(1)))
#define LAS __attribute__((address_space(3)))
typedef unsigned short bf16_t;
typedef short bf16x8 __attribute__((ext_vector_type(8)));
typedef float f32x4 __attribute__((ext_vector_type(4)));
typedef float f32x2 __attribute__((ext_vector_type(2)));
typedef unsigned u32x4 __attribute__((ext_vector_type(4)));
typedef unsigned u32x2 __attribute__((ext_vector_type(2)));
typedef __bf16 bf16x2_t __attribute__((ext_vector_type(2)));
typedef GAS unsigned gu32;

constexpr int T = 16384, D = 1024, NBATCH = 8, SEQ = 2048, NH = 16, HD = 64;
constexpr int AW = 2048;
constexpr int NE = 64, TOPK = 8, ED = 256, CAP = 16384;
constexpr float RMS_EPS = 1e-6f, LN_EPS = 1e-5f, ROUTED_SCALE = 2.5f;
constexpr float ATT_C2 = 0.125f * 1.4426950408889634f;
constexpr int NWAVES = 8, NTHREADS = 512;

constexpr size_t MiB = 1u << 20;
constexpr size_t WS_CTL = 0, CTL_ZERO_BYTES = 1 * MiB;
constexpr size_t WS_MOD = 1 * MiB;
constexpr size_t WS_VPART = 2 * MiB;
constexpr size_t WS_TOKLIST = 6 * MiB, WS_WLIST = 10 * MiB;
constexpr size_t WS_WIN_T = 14 * MiB;
constexpr size_t WS_WOUT_T = 22 * MiB;
constexpr size_t WS_WSP = 26 * MiB;
constexpr size_t WS_WQKV_T = 27 * MiB;
constexpr size_t WS_WO_T = 33 * MiB;
constexpr size_t WS_GU = 36 * MiB;
constexpr size_t WS_DN = 101 * MiB;
constexpr size_t WS_H = 134 * MiB;
constexpr size_t WS_SCR = 214 * MiB;
constexpr size_t WS_END = 470 * MiB;
constexpr int CW_TMO = 0, CW_CODE = 1, CW_BAR = 4096, CW_CNT = 8192;
constexpr size_t CTL_KMEAN = 65536;
constexpr int MOD_L = 8 * 6144;

constexpr int RING_BYTES = 131072;
constexpr int LDSCTL_OFF = RING_BYTES, MISC_OFF = LDSCTL_OFF + 320;
constexpr int LDS_AUX = RING_BYTES + 1024;
constexpr int LDS_BYTES = 147456;

#define RLX_AGENT __ATOMIC_RELAXED, __HIP_MEMORY_SCOPE_AGENT
#define LDS_WAIT() asm volatile("s_waitcnt lgkmcnt(0)" ::: "memory")
#define VM_WAIT() asm volatile("s_waitcnt vmcnt(0)" ::: "memory")

__device__ __forceinline__ unsigned f2bf(float f) { unsigned u = __builtin_bit_cast(unsigned, f); return (u + 0x7fffu + ((u >> 16) & 1u)) >> 16; }
__device__ __forceinline__ unsigned pk2(float lo, float hi) { f32x2 v = {lo, hi}; bf16x2_t b = __builtin_convertvector(v, bf16x2_t); return __builtin_bit_cast(unsigned, b); }
__device__ __forceinline__ float bf_lo(unsigned w) { return __uint_as_float(w << 16); }
__device__ __forceinline__ float bf_hi(unsigned w) { return __uint_as_float(w & 0xffff0000u); }
__device__ __forceinline__ float wave_sum(float v) {
#pragma unroll
    for (int o = 1; o < 64; o <<= 1) v += __shfl_xor(v, o);
    return v;
}
__device__ __forceinline__ float gelu_tanh(float x) {
    const float t = x * x, inner = x * (0.7978845608f + 0.0356774081f * t);
    const float e = __builtin_amdgcn_exp2f(-2.885390082f * inner);
    return x * __builtin_amdgcn_rcpf(1.0f + e);
}
__device__ __forceinline__ float silu_f(float x) { return x / (1.0f + __expf(-x)); }
#define XB_TMO      128
#define XB_XCNT(j)  (256  + 64 * (j))
#define XB_XSUB(j)  (1280 + 64 * (j))
#define XB_XGEN(j)  (2304 + 64 * (j))
#define XB_TOP      3328
#define XB_TOPGEN   3392
#define XCD_BAR_WORDS 3456
#define XB_SPIN_CAP (1u << 20)
__device__ __forceinline__ unsigned xb_ld(unsigned* p)              { return __hip_atomic_load(p, __ATOMIC_RELAXED, __HIP_MEMORY_SCOPE_AGENT); }
__device__ __forceinline__ unsigned xb_add(unsigned* p, unsigned v) { return __hip_atomic_fetch_add(p, v, __ATOMIC_RELAXED, __HIP_MEMORY_SCOPE_AGENT); }
__device__ __forceinline__ unsigned xb_xcc_id() { return (unsigned)__builtin_amdgcn_s_getreg((3 << 11) | 20) & 0xFu; }
#define XB_SPIN(cond, bar) do { unsigned _sp = 0; while (cond) { __builtin_amdgcn_s_sleep(1); \
    if ((++_sp & 255u) == 0u) { if (xb_ld(&(bar)[XB_TMO])) break; if (_sp > XB_SPIN_CAP) { atomicAdd(&(bar)[XB_TMO], 1u); break; } } } } while (0)

struct XcdBarrier {
    unsigned* bar; unsigned x;
    volatile LAS unsigned* st;
};

__device__ __forceinline__ XcdBarrier xcd_barrier_post(unsigned* bar, volatile LAS unsigned* st) {
    XcdBarrier b; b.bar = bar; b.x = xb_xcc_id(); b.st = st;
    if (threadIdx.x == 0) (void)xb_add(&bar[XB_XCNT(b.x)], 1u);
    return b;
}
__device__ __forceinline__ void xcd_barrier_complete(unsigned* bar, unsigned x, unsigned& nloc, unsigned& nx) {
    const unsigned G = gridDim.x * gridDim.y * gridDim.z;
    unsigned sum, cnt, mine, sp = 0u;
    for (;;) {
        sum = 0u; cnt = 0u; mine = 0u;
#pragma unroll
        for (unsigned j = 0; j < 16; ++j) { const unsigned c = xb_ld(&bar[XB_XCNT(j)]); sum += c; cnt += (c > 0u) ? 1u : 0u; mine = (j == x) ? c : mine; }
        if (sum == G) break;
        __builtin_amdgcn_s_sleep(1);
        if ((++sp & 255u) == 0u) { if (xb_ld(&bar[XB_TMO])) break; if (sp > XB_SPIN_CAP) { atomicAdd(&bar[XB_TMO], 1u); break; } }
    }
    nloc = mine > 0u ? mine : 1u; nx = cnt > 0u ? cnt : 1u;
}

__device__ __forceinline__ void xcd_barrier(const XcdBarrier& b) {
    asm volatile("s_waitcnt vmcnt(0)" ::: "memory");
    __syncthreads();
    if (threadIdx.x == 0) {
        unsigned* bar = b.bar;
        __builtin_amdgcn_s_waitcnt(0);
        unsigned nloc = b.st[0], nx = b.st[1];
        if (nloc == 0u) { xcd_barrier_complete(bar, b.x, nloc, nx); b.st[0] = nloc; b.st[1] = nx; }
        const unsigned old = xb_add(&bar[XB_XSUB(b.x)], 1u);
        const unsigned gen = old / nloc;
        if (old + 1u == (gen + 1u) * nloc) {
            __builtin_amdgcn_fence(__ATOMIC_RELEASE, "agent");
            asm volatile("s_waitcnt vmcnt(0)" ::: "memory");
            const unsigned og = xb_add(&bar[XB_TOP], 1u);
            const unsigned tg = og / nx;
            if (og + 1u == (tg + 1u) * nx) xb_add(&bar[XB_TOPGEN], 1u);
            else XB_SPIN(xb_ld(&bar[XB_TOPGEN]) == tg, bar);
            __builtin_amdgcn_fence(__ATOMIC_ACQUIRE, "agent");
            xb_add(&bar[XB_XGEN(b.x)], 1u);
            asm volatile("s_waitcnt vmcnt(0)" ::: "memory");
        } else {
            XB_SPIN(xb_ld(&bar[XB_XGEN(b.x)]) == gen, bar);
            __builtin_amdgcn_fence(__ATOMIC_ACQUIRE, "agent");
            asm volatile("s_waitcnt vmcnt(0)" ::: "memory");
        }
    }
    __syncthreads();
}

__host__ __device__ __forceinline__ int perm32(int rho) { const int n = rho >> 4, i = rho & 15; return 8 * (i >> 2) + 4 * n + (i & 3); }

struct Unit { int pm, pn, arow, brow, e, nvalid, lbase; };

constexpr int NXCD = 8, WGM = 8;
struct DenseSched {
    int nM, nN, nwg, G, c, a_split_pn, a_split_rows;
    __device__ __forceinline__ void init(int M, int N, int G_, int c_, int spn = 1 << 30, int srows = 0) { nM = M / 256; nN = N / 256; nwg = nM * nN; G = G_; c = c_; a_split_pn = spn; a_split_rows = srows; }
    __device__ __forceinline__ bool next(int i, Unit& u) const {
        const long L = (long)i * G + c; if (L >= nwg) return false;
        int wgid = (int)L; { const int q = nwg / NXCD, r = nwg % NXCD, xcd = wgid % NXCD, off = wgid / NXCD; wgid = (xcd < r ? xcd * (q + 1) : r * (q + 1) + (xcd - r) * q) + off; }
        const int nig = WGM * nN, gid = wgid / nig, fm = gid * WGM, gsz = (nM - fm) < WGM ? (nM - fm) : WGM;
        u.pm = fm + ((wgid % nig) % gsz); u.pn = (wgid % nig) / gsz;
        u.arow = u.pm * 256 + (u.pn >= a_split_pn ? a_split_rows : 0); u.brow = u.pn * 256; u.e = -1; u.nvalid = 256; u.lbase = 0; return true;
    }
    __device__ __forceinline__ int a_row(const Unit& u, int r) const { return u.arow + r; }
};
template <bool GATE_UP> struct MoeSched {
    const LAS int* tb; const LAS int* cnt; const int* toklist; int G, c, ncol, nunits;
    __device__ __forceinline__ void init(const LAS int* tb_, const LAS int* cnt_, const int* tl, int G_, int c_) { tb = tb_; cnt = cnt_; toklist = tl; G = G_; c = c_; ncol = GATE_UP ? 2 : 4; nunits = tb_[65] * ncol; }
    __device__ __forceinline__ bool next(int i, Unit& u) const {
        const int L = i * G + c; if (L >= nunits) return false;
        const int rt = L / ncol; u.pn = L % ncol; u.pm = rt;
        int e = 0;
#pragma unroll 1
        for (int j = 64; j > 0; j >>= 1) if (e + j <= 64 && tb[e + j] <= rt) e += j;
        while (e < 64 && tb[e + 1] <= rt) ++e;
        u.e = e;
        const int ti = rt - tb[e];
        if (e < 64) { const int left = cnt[e] - ti * 256; u.nvalid = left < 256 ? left : 256; u.lbase = e * CAP + ti * 256; u.arow = GATE_UP ? 0 : rt * 256; }
        else { u.nvalid = 256; u.lbase = 0; u.arow = GATE_UP ? ti * 256 : rt * 256; }
        u.brow = GATE_UP ? (e * 512 + u.pn * 256) : (e * 1024 + u.pn * 256);
        return true;
    }
    __device__ __forceinline__ int a_row(const Unit& u, int r) const {
        if (!GATE_UP) return u.arow + r;
        if (u.e == 64) return u.arow + r;
        return (r < u.nvalid) ? (toklist[u.lbase + r] >> 3) : 0;
    }
};

template <class Epi, class Sched>
__device__ __forceinline__ void gemm_ref(const bf16_t* A, const bf16_t* Bt, int K, const Sched& S, const Epi& E) {
    const int tid = threadIdx.x, wid = __builtin_amdgcn_readfirstlane(tid >> 6), lane = tid & 63, wr = wid >> 2, wc = wid & 3, fr = lane & 15, fq = lane >> 4;
    Unit u;
    for (int i = 0; S.next(i, u); ++i) {
        f32x4 acc[2][2][4][2];
#pragma unroll
        for (int a = 0; a < 2; ++a)
#pragma unroll
            for (int b = 0; b < 2; ++b)
#pragma unroll
                for (int m = 0; m < 4; ++m)
#pragma unroll
                    for (int n = 0; n < 2; ++n) acc[a][b][m][n] = (f32x4){0.f, 0.f, 0.f, 0.f};
        unsigned aoff[2][4], boff[2][2];
#pragma unroll
        for (int ai = 0; ai < 2; ++ai)
#pragma unroll
            for (int m = 0; m < 4; ++m) aoff[ai][m] = (unsigned)S.a_row(u, 128 * ai + 64 * wr + 16 * m + fr) * (unsigned)K + 8u * fq;
#pragma unroll
        for (int bj = 0; bj < 2; ++bj)
#pragma unroll
            for (int n = 0; n < 2; ++n) boff[bj][n] = (unsigned)(u.brow + 128 * bj + 32 * wc + (Epi::PERM ? perm32(16 * n + fr) : 16 * n + fr)) * (unsigned)K + 8u * fq;
#pragma unroll 1
        for (int kk = 0; kk < K; kk += 32) {
            bf16x8 af[2][4], bfr[2][2];
#pragma unroll
            for (int ai = 0; ai < 2; ++ai)
#pragma unroll
                for (int m = 0; m < 4; ++m) af[ai][m] = *(const bf16x8*)(A + (size_t)aoff[ai][m] + kk);
#pragma unroll
            for (int bj = 0; bj < 2; ++bj)
#pragma unroll
                for (int n = 0; n < 2; ++n) bfr[bj][n] = *(const bf16x8*)(Bt + (size_t)boff[bj][n] + kk);
#pragma unroll
            for (int ai = 0; ai < 2; ++ai)
#pragma unroll
                for (int bj = 0; bj < 2; ++bj)
#pragma unroll
                    for (int m = 0; m < 4; ++m)
#pragma unroll
                        for (int n = 0; n < 2; ++n) acc[ai][bj][m][n] = __builtin_amdgcn_mfma_f32_16x16x32_bf16(bfr[bj][n], af[ai][m], acc[ai][bj][m][n], 0, 0, 0);
        }
        E(acc, u, wr, wc, fr, fq);
    }
}

struct EpiGemm1 {
    static constexpr bool PERM = true;
    bf16_t* U; bf16_t* VT; float* vpart; const float* bias;
    __device__ __forceinline__ void operator()(const f32x4 (&acc)[2][2][4][2], const Unit& u, int wr, int wc, int fr, int fq) const {
        const int colt = u.pn * 256; const bool isv = colt >= AW;
        f32x4 bv[2][2];
#pragma unroll
        for (int bj = 0; bj < 2; ++bj)
#pragma unroll
            for (int n = 0; n < 2; ++n) bv[bj][n] = *(const f32x4*)(bias + colt + 128 * bj + 32 * wc + 8 * fq + 4 * n);
#pragma unroll
        for (int ai = 0; ai < 2; ++ai)
#pragma unroll
            for (int m = 0; m < 4; ++m) {
                const int row = u.pm * 256 + 128 * ai + 64 * wr + 16 * m + fr;
                float s1 = 0.f, s2 = 0.f;
#pragma unroll
                for (int bj = 0; bj < 2; ++bj) {
                    float v[8];
#pragma unroll
                    for (int n = 0; n < 2; ++n)
#pragma unroll
                        for (int j = 0; j < 4; ++j) v[4 * n + j] = gelu_tanh(acc[ai][bj][m][n][j] + bv[bj][n][j]);
                    const int col = colt + 128 * bj + 32 * wc + 8 * fq;
                    if (!isv) {
                        u32x4 w; w.x = pk2(v[0], v[1]); w.y = pk2(v[2], v[3]); w.z = pk2(v[4], v[5]); w.w = pk2(v[6], v[7]);
                        *(u32x4*)(U + (size_t)row * AW + col) = w;
                    } else {
                        bf16_t* vt = VT + ((size_t)(row >> 7) * AW + (col - AW)) * 128 + (row & 127);
#pragma unroll
                        for (int j = 0; j < 8; ++j) { vt[(size_t)j * 128] = (bf16_t)f2bf(v[j]); s1 += v[j]; s2 += v[j] * v[j]; }
                    }
                }
                if (isv) {
                    s1 += __shfl_xor(s1, 16); s1 += __shfl_xor(s1, 32); s2 += __shfl_xor(s2, 16); s2 += __shfl_xor(s2, 32);
                    if (fq == 0) { float* p = vpart + ((size_t)row * 32 + (u.pn - 8) * 4 + wc) * 2; *(f32x2*)p = (f32x2){s1, s2}; }
                }
            }
    }
};
struct EpiResid {
    static constexpr bool PERM = false;
    const float* base; float* out; const float* gate;
    int gstride;
    __device__ __forceinline__ void operator()(const f32x4 (&acc)[2][2][4][2], const Unit& u, int wr, int wc, int fr, int fq) const {
        const int b = (u.pm * 256) / SEQ;
        f32x4 gv[2][2];
#pragma unroll
        for (int bj = 0; bj < 2; ++bj)
#pragma unroll
            for (int n = 0; n < 2; ++n) gv[bj][n] = *(const f32x4*)(gate + (size_t)b * gstride + u.pn * 256 + 128 * bj + 32 * wc + 16 * n + 4 * fq);
#pragma unroll
        for (int ai = 0; ai < 2; ++ai)
#pragma unroll
            for (int m = 0; m < 4; ++m) {
                const size_t off = (size_t)(u.pm * 256 + 128 * ai + 64 * wr + 16 * m + fr) * D + u.pn * 256 + 32 * wc + 4 * fq;
#pragma unroll
                for (int bj = 0; bj < 2; ++bj)
#pragma unroll
                    for (int n = 0; n < 2; ++n) { const f32x4 bs = *(const f32x4*)(base + off + 128 * bj + 16 * n); *(f32x4*)(out + off + 128 * bj + 16 * n) = bs + gv[bj][n] * acc[ai][bj][m][n]; }
            }
    }
};
struct EpiGateUp {
    static constexpr bool PERM = true;
    bf16_t* Hb;
    __device__ __forceinline__ void operator()(const f32x4 (&acc)[2][2][4][2], const Unit& u, int wr, int wc, int fr, int fq) const {
#pragma unroll
        for (int ai = 0; ai < 2; ++ai)
#pragma unroll
            for (int m = 0; m < 4; ++m) {
                const int r = 128 * ai + 64 * wr + 16 * m + fr;
                float v[8];
#pragma unroll
                for (int n = 0; n < 2; ++n)
#pragma unroll
                    for (int j = 0; j < 4; ++j) { const float g = acc[ai][0][m][n][j], up = acc[ai][1][m][n][j]; v[4 * n + j] = silu_f(g) * up; }
                u32x4 w; w.x = pk2(v[0], v[1]); w.y = pk2(v[2], v[3]); w.z = pk2(v[4], v[5]); w.w = pk2(v[6], v[7]);
                *(u32x4*)(Hb + (size_t)(u.pm * 256 + r) * ED + u.pn * 128 + 32 * wc + 8 * fq) = w;
            }
    }
};
struct EpiDown {
    static constexpr bool PERM = true;
    bf16_t* Y; float* X; const int* toklist; const float* wlist; const float* gate; int gstride; const LAS int* tb;
    __device__ __forceinline__ void operator()(const f32x4 (&acc)[2][2][4][2], const Unit& u, int wr, int wc, int fr, int fq) const {
        const int colb = u.pn * 256 + 32 * wc + 8 * fq;
        if (u.e < 64) {
#pragma unroll
            for (int ai = 0; ai < 2; ++ai)
#pragma unroll
                for (int m = 0; m < 4; ++m) {
                    const int r = 128 * ai + 64 * wr + 16 * m + fr;
                    if (r < u.nvalid) {
                        const int ent = toklist[u.lbase + r]; const float w = wlist[u.lbase + r];
#pragma unroll
                        for (int bj = 0; bj < 2; ++bj) { const f32x4 a0 = acc[ai][bj][m][0] * w, a1 = acc[ai][bj][m][1] * w;
                            u32x4 o; o.x = pk2(a0[0], a0[1]); o.y = pk2(a0[2], a0[3]); o.z = pk2(a1[0], a1[1]); o.w = pk2(a1[2], a1[3]);
                            *(u32x4*)(Y + (size_t)ent * D + colb + 128 * bj) = o; }
                    }
                }
        } else {
            const int t0 = (u.pm - tb[64]) * 256; const int b = t0 / SEQ;
#pragma unroll
            for (int ai = 0; ai < 2; ++ai)
#pragma unroll
                for (int m = 0; m < 4; ++m) {
                    const int r = 128 * ai + 64 * wr + 16 * m + fr;
                    float* xr = X + (size_t)(t0 + r) * D + colb;
#pragma unroll
                    for (int bj = 0; bj < 2; ++bj)
#pragma unroll
                        for (int n = 0; n < 2; ++n) { const f32x4 g = *(const f32x4*)(gate + (size_t)b * gstride + colb + 128 * bj + 4 * n); f32x4* p = (f32x4*)(xr + 128 * bj + 4 * n); *p = *p + g * acc[ai][bj][m][n]; }
                }
        }
    }
};
struct EpiQKV {
    static constexpr bool PERM = true;
    bf16_t* Q; float* kmean;
    __device__ __forceinline__ void operator()(const f32x4 (&acc)[2][2][4][2], const Unit& u, int wr, int wc, int fr, int fq) const {
        const int which = u.pn >> 2, colt = (u.pn & 3) * 256;
        bf16_t* base = Q + (size_t)which * ((size_t)T * D);
        const float sc = which == 0 ? ATT_C2 : 1.0f;
        const int col0 = colt + 32 * wc + 8 * fq;
        float cs[2][8];
#pragma unroll
        for (int bj = 0; bj < 2; ++bj)
#pragma unroll
            for (int j = 0; j < 8; ++j) cs[bj][j] = 0.f;
#pragma unroll
        for (int ai = 0; ai < 2; ++ai)
#pragma unroll
            for (int m = 0; m < 4; ++m) {
                bf16_t* rowp = base + (size_t)(u.pm * 256 + 128 * ai + 64 * wr + 16 * m + fr) * D + col0;
#pragma unroll
                for (int bj = 0; bj < 2; ++bj) { const f32x4 v0 = acc[ai][bj][m][0] * sc, v1 = acc[ai][bj][m][1] * sc;
                    u32x4 w; w.x = pk2(v0[0], v0[1]); w.y = pk2(v0[2], v0[3]); w.z = pk2(v1[0], v1[1]); w.w = pk2(v1[2], v1[3]);
                    *(u32x4*)(rowp + 128 * bj) = w;
#pragma unroll
                    for (int j = 0; j < 4; ++j) { cs[bj][j] += v0[j]; cs[bj][4 + j] += v1[j]; } }
            }
        if (which == 1) {
#pragma unroll
            for (int bj = 0; bj < 2; ++bj)
#pragma unroll
                for (int j = 0; j < 8; ++j) { float s = cs[bj][j]; s += __shfl_xor(s, 1); s += __shfl_xor(s, 2); s += __shfl_xor(s, 4); s += __shfl_xor(s, 8); cs[bj][j] = s; }
            if (fr == 0) {
                const int b = u.pm >> 3, blk = u.pm & 7;
#pragma unroll
                for (int bj = 0; bj < 2; ++bj)
#pragma unroll
                    for (int j = 0; j < 8; ++j) { const int c = col0 + 128 * bj + j, h = c >> 6, d = c & 63;
                        atomicAdd(kmean + (((size_t)b * NH + h) * 8 + blk) * 64 + d, cs[bj][j] * (1.0f / 256.0f)); }
            }
        }
    }
};
namespace pg8 {
constexpr int BM = 256, BK = 64, HALF = 128, HTB = HALF * BK * 2, STAGE_BYTES = 8 * HTB;
__host__ __device__ __forceinline__ int lds_byte(int r, int c) { const int st = (r >> 4) * 2 + (c >> 5), rr = r & 15, cc = c & 31, ob = rr * 64 + cc * 2; return st * 1024 + (ob ^ (((ob >> 9) & 1) << 5)); }
__host__ __device__ __forceinline__ void stage_rc(int b, int& R, int& C) { const int st = b / 1024, sb = b % 1024, swz = sb ^ (((sb >> 9) & 1) << 5); R = (st >> 1) * 16 + swz / 64; C = (st & 1) * 32 + (swz % 64) / 2; }

template <bool GATHER, class Epi, class Sched>
__device__ __forceinline__ void gemm_phase(LAS unsigned char* lds, const bf16_t* Ab, const bf16_t* Btb, const int K, const Sched& S, const Epi& E) {
    const int tid = threadIdx.x, wid = __builtin_amdgcn_readfirstlane(tid >> 6), lane = tid & 63, wr = wid >> 2, wc = wid & 3, fr = lane & 15, fq = lane >> 4;
    const int nt = K / BK;
    unsigned voffA[2][2], nvoffA[2][2], voffB[2]; int RA[2], CA[2];
#pragma unroll
    for (int i = 0; i < 2; ++i) { int R, C; stage_rc(tid * 16 + i * 8192, R, C); const int Rb = Epi::PERM ? ((R & ~31) + perm32(R & 31)) : R;
        RA[i] = R; CA[i] = C; voffA[0][i] = (unsigned)(R * K + C) * 2u; voffA[1][i] = voffA[0][i]; nvoffA[0][i] = voffA[0][i]; nvoffA[1][i] = voffA[0][i]; voffB[i] = (unsigned)(Rb * K + C) * 2u; }
    const size_t kstep = (size_t)(BK * 2);
    const size_t hstep = (size_t)HALF * K * 2;
    const unsigned ldsw = (unsigned)wid * 1024u;
    const int aoff = lds_byte(wr * 64 + fr, fq * 8), boff = lds_byte(wc * 32 + fr, fq * 8);
#define PG8_SA(b, h) (((b) * 2 + (h)) * HTB)
#define PG8_SB(b, h) ((4 + (b) * 2 + (h)) * HTB)
#define PG8_STAGE(bufoff, gbase, voff) do { _Pragma("unroll") for (int _i = 0; _i < 2; ++_i) \
        __builtin_amdgcn_global_load_lds((const unsigned*)((const char*)(gbase) + (voff)[_i]), (LAS unsigned*)(lds + (bufoff) + ldsw + _i * 8192), 16, 0, 0); } while (0)
#define PG8_LDA(dst, b, h) do { _Pragma("unroll") for (int m = 0; m < 4; ++m) _Pragma("unroll") for (int k = 0; k < 2; ++k) dst[m][k] = *(const LAS bf16x8*)(lds + PG8_SA(b, h) + aoff + m * 2048 + k * 1024); } while (0)
#define PG8_LDB(dst, b, h) do { _Pragma("unroll") for (int n = 0; n < 2; ++n) _Pragma("unroll") for (int k = 0; k < 2; ++k) dst[n][k] = *(const LAS bf16x8*)(lds + PG8_SB(b, h) + boff + n * 2048 + k * 1024); } while (0)
#define PG8_MMA(ai, bj, At, Bt) do { __builtin_amdgcn_s_setprio(1); _Pragma("unroll") for (int m = 0; m < 4; ++m) _Pragma("unroll") for (int n = 0; n < 2; ++n) _Pragma("unroll") for (int k = 0; k < 2; ++k) \
        acc[ai][bj][m][n] = __builtin_amdgcn_mfma_f32_16x16x32_bf16(Bt[n][k], At[m][k], acc[ai][bj][m][n], 0, 0, 0); __builtin_amdgcn_s_setprio(0); } while (0)
#define PG8_WAIT_V(n) asm volatile("s_waitcnt vmcnt(" #n ")" ::: "memory")
#define PG8_WAIT_L(n) asm volatile("s_waitcnt lgkmcnt(" #n ")" ::: "memory")
#define PG8_BAR __builtin_amdgcn_s_barrier()
#define PG8_SCHED __builtin_amdgcn_sched_barrier(0)
#define PG8_GATHER_OFFS(dst, u) do { if (GATHER) { _Pragma("unroll") for (int _h = 0; _h < 2; ++_h) _Pragma("unroll") for (int _i = 0; _i < 2; ++_i) \
        dst[_h][_i] = ((unsigned)S.a_row(u, 128 * _h + RA[_i]) * (unsigned)K + (unsigned)CA[_i]) * 2u; } } while (0)
    Unit cur, nxt; int ui = 0;
    if (!S.next(0, cur)) return;
    f32x4 acc[2][2][4][2];
#pragma unroll
    for (int a = 0; a < 2; ++a)
#pragma unroll
        for (int b = 0; b < 2; ++b)
#pragma unroll
            for (int m = 0; m < 4; ++m)
#pragma unroll
                for (int n = 0; n < 2; ++n) acc[a][b][m][n] = (f32x4){0.f, 0.f, 0.f, 0.f};
    bf16x8 At[4][2], B0[2][2], B1[2][2];
    PG8_GATHER_OFFS(voffA, cur);
    const char* cA0 = GATHER ? (const char*)Ab : (const char*)Ab + (size_t)cur.arow * K * 2; const char* cA1 = GATHER ? cA0 : cA0 + hstep;
    const char* cB = (const char*)Btb + (size_t)cur.brow * K * 2;
    PG8_STAGE(PG8_SB(0, 0), cB, voffB); PG8_STAGE(PG8_SB(0, 1), cB + hstep, voffB); PG8_STAGE(PG8_SA(0, 0), cA0, voffA[0]); PG8_STAGE(PG8_SA(0, 1), cA1, voffA[1]);
    if (wr == 1) PG8_BAR;
    PG8_WAIT_V(2); PG8_BAR;
    PG8_STAGE(PG8_SB(1, 0), cB + kstep, voffB); PG8_STAGE(PG8_SA(1, 0), cA0 + kstep, voffA[0]); PG8_STAGE(PG8_SB(1, 1), cB + hstep + kstep, voffB);
    PG8_WAIT_V(6); PG8_BAR;
    for (;;) {
        const bool has_next = S.next(ui + 1, nxt);
        if (has_next) PG8_GATHER_OFFS(nvoffA, nxt);
        else if (GATHER) { _Pragma("unroll") for (int _h = 0; _h < 2; ++_h) _Pragma("unroll") for (int _i = 0; _i < 2; ++_i) nvoffA[_h][_i] = voffA[_h][_i]; }
        const char* nA0 = GATHER ? cA0 : (has_next ? (const char*)Ab + (size_t)nxt.arow * K * 2 : cA0); const char* nA1 = GATHER ? nA0 : nA0 + hstep;
        const char* nB = has_next ? (const char*)Btb + (size_t)nxt.brow * K * 2 : cB;
        for (int t = 0; t < nt; t += 2) {
            const bool last = (t == nt - 2);
            const char* a1h1 = cA1 + (size_t)(t + 1) * kstep;
            const char* a2h0 = last ? nA0 : cA0 + (size_t)(t + 2) * kstep; const char* a2h1 = last ? nA1 : cA1 + (size_t)(t + 2) * kstep;
            const char* b2 = last ? nB : cB + (size_t)(t + 2) * kstep;
            const char* a3h0 = a2h0 + kstep; const char* a3h1 = a2h1 + kstep; const char* b3 = b2 + kstep;
            unsigned v2h0[2], v2h1[2];
#pragma unroll
            for (int i = 0; i < 2; ++i) { v2h0[i] = (GATHER && last) ? nvoffA[0][i] : voffA[0][i]; v2h1[i] = (GATHER && last) ? nvoffA[1][i] : voffA[1][i]; }
            PG8_LDB(B0, 0, 0); PG8_LDB(B1, 0, 1); PG8_SCHED; PG8_LDA(At, 0, 0); PG8_STAGE(PG8_SA(1, 1), a1h1, voffA[1]);
            PG8_WAIT_V(8); PG8_WAIT_L(0); PG8_BAR; PG8_MMA(0, 0, At, B0); PG8_MMA(0, 1, At, B1); PG8_BAR; PG8_SCHED;
            PG8_LDA(At, 0, 1); PG8_STAGE(PG8_SB(0, 0), b2, voffB); PG8_STAGE(PG8_SB(0, 1), b2 + hstep, voffB); PG8_STAGE(PG8_SA(0, 0), a2h0, v2h0);
            PG8_WAIT_V(8); PG8_WAIT_L(0); PG8_BAR; PG8_MMA(1, 0, At, B0); PG8_MMA(1, 1, At, B1); PG8_BAR; PG8_SCHED;
            PG8_LDB(B0, 1, 0); PG8_LDB(B1, 1, 1); PG8_SCHED; PG8_LDA(At, 1, 0); PG8_STAGE(PG8_SA(0, 1), a2h1, v2h1);
            PG8_WAIT_V(8); PG8_WAIT_L(0); PG8_BAR; PG8_MMA(0, 0, At, B0); PG8_MMA(0, 1, At, B1); PG8_BAR; PG8_SCHED;
            PG8_LDA(At, 1, 1); PG8_STAGE(PG8_SB(1, 0), b3, voffB); PG8_STAGE(PG8_SB(1, 1), b3 + hstep, voffB); PG8_STAGE(PG8_SA(1, 0), a3h0, v2h0);
            PG8_WAIT_V(8); PG8_WAIT_L(0); PG8_BAR; PG8_MMA(1, 0, At, B0); PG8_MMA(1, 1, At, B1); PG8_BAR; PG8_SCHED;
        }
        if (wr == 0) PG8_BAR;
        E(acc, cur, wr, wc, fr, fq);
        if (!has_next) break;
#pragma unroll
        for (int a = 0; a < 2; ++a)
#pragma unroll
            for (int b = 0; b < 2; ++b)
#pragma unroll
                for (int m = 0; m < 4; ++m)
#pragma unroll
                    for (int n = 0; n < 2; ++n) acc[a][b][m][n] = (f32x4){0.f, 0.f, 0.f, 0.f};
        cur = nxt; cA0 = nA0; cA1 = nA1; cB = nB; ++ui;
        if (GATHER) { _Pragma("unroll") for (int _h = 0; _h < 2; ++_h) _Pragma("unroll") for (int _i = 0; _i < 2; ++_i) voffA[_h][_i] = nvoffA[_h][_i]; }
        if (wr == 1) PG8_BAR;
    }
    PG8_WAIT_V(0);
    PG8_BAR;
#undef PG8_SA
#undef PG8_SB
#undef PG8_STAGE
#undef PG8_LDA
#undef PG8_LDB
#undef PG8_MMA
#undef PG8_WAIT_V
#undef PG8_WAIT_L
#undef PG8_BAR
#undef PG8_SCHED
#undef PG8_GATHER_OFFS
}
}
#include <hip/hip_bf16.h>
#include <cmath>
namespace attn_body {
using bf16=__hip_bfloat16;
using bf16x8=__attribute__((ext_vector_type(8)))short;
using s16x4=__attribute__((ext_vector_type(4)))short;
using f32x16=__attribute__((ext_vector_type(16)))float;
using u32x4=__attribute__((ext_vector_type(4)))unsigned;
constexpr int BATCH=8,NHEAD=16,SEQ=2048,D=64,DM=NHEAD*D;
constexpr int NW=8,QBLK=32,QB=QBLK*NW,KVBLK=64,NQB=SEQ/QB;
constexpr int ATTN_PITCH=DM, ATTN_UNIT_ROWS=QB;
__device__ __forceinline__ int crow(int r,int hi){return (r&3)+8*(r>>2)+4*hi;}
#define SBAR() __builtin_amdgcn_sched_barrier(0)
__device__ __forceinline__ void cmask(f32x16&p0,f32x16&p1,int jb,int qrel,int hi){
  const float NEG=-INFINITY; int kb=64*jb+4*hi;
  #pragma unroll
  for(int r=0;r<16;++r){int kv=kb+(r&3)+8*(r>>2); if(kv>qrel)p0[r]=NEG; if(kv+32>qrel)p1[r]=NEG;}
}

constexpr int NSLOT=3, SLOTB=8192;
constexpr int LDS_K=0, LDS_V=NSLOT*SLOTB, LDS_WS=2*NSLOT*SLOTB, LDS_OST=LDS_WS+NW*64*4, LDS_BYTES=LDS_OST+NW*4096;
constexpr float C2=0.125f*1.4426950408889634f;
__device__ __forceinline__ void glds16(const void*gsrc,unsigned lds_dst){unsigned keep;
  asm volatile("s_mov_b32 %0, m0\n\ts_mov_b32 m0, %2\n\ts_nop 0\n\tglobal_load_lds_dwordx4 %1, off\n\ts_mov_b32 m0, %0":"=&s"(keep):"v"(gsrc),"s"(lds_dst):"memory");}
__device__ __forceinline__ float max3f(float a,float b,float c){float r;asm("v_max3_f32 %0, %1, %2, %3":"=v"(r):"v"(a),"v"(b),"v"(c));return r;}
__device__ __forceinline__ float max2f(float a,float b){float r;asm("v_max_f32_e32 %0, %1, %2":"=v"(r):"v"(a),"v"(b));return r;}
__device__ __forceinline__ float fadd_s(float a,float b){float r;asm("v_add_f32_e32 %0, %1, %2":"=v"(r):"v"(a),"v"(b));return r;}
__device__ __forceinline__ float fsub_s(float a,float b){float r;asm("v_sub_f32_e32 %0, %1, %2":"=v"(r):"v"(a),"v"(b));return r;}
typedef float f32x2_t __attribute__((ext_vector_type(2))); typedef float f32x4_t __attribute__((ext_vector_type(4)));
__device__ __forceinline__ float bf2f(short v){return __uint_as_float(((unsigned)(unsigned short)v)<<16);} typedef __bf16 bf16x2_t __attribute__((ext_vector_type(2)));
__device__ __forceinline__ unsigned cvtpk_s(float lo,float hi){f32x2_t v={lo,hi};bf16x2_t b=__builtin_convertvector(v,bf16x2_t);return __builtin_bit_cast(unsigned,b);}
#define WAIT_BAR(N) asm volatile("s_waitcnt vmcnt(" #N ") lgkmcnt(0)\n\ts_barrier":::"memory")

__device__ __forceinline__ void qkt(f32x16&p0,f32x16&p1,const char*Kslot,const bf16x8*qr,const f32x16&negm,int r32,int hi){
  const char*kb=Kslot+hi*1024+r32*16;
  #pragma unroll
  for(int d0=0;d0<4;++d0){
    const bf16x8 b0=*reinterpret_cast<const bf16x8*>(kb+d0*2048);
    const bf16x8 b1=*reinterpret_cast<const bf16x8*>(kb+d0*2048+512);
    if(d0==0){p0=__builtin_amdgcn_mfma_f32_32x32x16_bf16(b0,qr[0],negm,0,0,0);p1=__builtin_amdgcn_mfma_f32_32x32x16_bf16(b1,qr[0],negm,0,0,0);}
    else{p0=__builtin_amdgcn_mfma_f32_32x32x16_bf16(b0,qr[d0],p0,0,0,0);p1=__builtin_amdgcn_mfma_f32_32x32x16_bf16(b1,qr[d0],p1,0,0,0);}}
}
typedef __attribute__((address_space(3))) const char* lds_cptr;
typedef short v4i16_t __attribute__((ext_vector_type(4)));
__device__ __forceinline__ void kload8(bf16x8*kf,lds_cptr kp){
  kf[0]=*(const __attribute__((address_space(3))) bf16x8*)(kp);      kf[1]=*(const __attribute__((address_space(3))) bf16x8*)(kp+512);
  kf[2]=*(const __attribute__((address_space(3))) bf16x8*)(kp+2048); kf[3]=*(const __attribute__((address_space(3))) bf16x8*)(kp+2560);
  kf[4]=*(const __attribute__((address_space(3))) bf16x8*)(kp+4096); kf[5]=*(const __attribute__((address_space(3))) bf16x8*)(kp+4608);
  kf[6]=*(const __attribute__((address_space(3))) bf16x8*)(kp+6144); kf[7]=*(const __attribute__((address_space(3))) bf16x8*)(kp+6656);
}
__device__ __forceinline__ void kload2(bf16x8*kf,lds_cptr kp,int j){ kf[2*j]=*(const __attribute__((address_space(3))) bf16x8*)(kp+j*2048); kf[2*j+1]=*(const __attribute__((address_space(3))) bf16x8*)(kp+j*2048+512); }
__device__ __forceinline__ s16x4 vtr(lds_cptr p){ return __builtin_bit_cast(s16x4,__builtin_amdgcn_ds_read_tr16_b64_v4i16((__attribute__((address_space(3))) v4i16_t*)p)); }
__device__ __forceinline__ float rowmax(const f32x16&p0,const f32x16&p1){
  float a=max3f(p0[0],p0[1],p1[0]),b=max3f(p0[2],p0[3],p1[1]);a=max3f(a,p1[2],p1[3]);
  #pragma unroll
  for(int r=4;r<16;r+=4){a=max3f(a,p0[r],p0[r+1]);b=max3f(b,p0[r+2],p0[r+3]);a=max3f(a,p1[r],p1[r+1]);b=max3f(b,p1[r+2],p1[r+3]);}
  const float m=max2f(a,b);
  auto rr=__builtin_amdgcn_permlane32_swap(__float_as_uint(m),__float_as_uint(m),false,false);
  return max2f(__uint_as_float(rr[0]),__uint_as_float(rr[1]));
}
__device__ __forceinline__ void pv(f32x16*o,int vb,bf16x8 pa0,bf16x8 pa1,bf16x8 pa2,bf16x8 pa3){
  #pragma unroll
  for(int d0=0;d0<2;++d0){s16x4 lo[4],hi[4];
    #pragma unroll
    for(int ks=0;ks<4;++ks){
      asm volatile("ds_read_b64_tr_b16 %0,%1 offset:%c2":"=&v"(lo[ks]):"v"(vb),"i"(d0*4096+ks*1024):"memory");
      asm volatile("ds_read_b64_tr_b16 %0,%1 offset:%c2":"=&v"(hi[ks]):"v"(vb),"i"(d0*4096+ks*1024+512):"memory");}
    asm volatile("s_waitcnt lgkmcnt(0)":::"memory");SBAR();
    #define PK(k) (bf16x8){lo[k][0],lo[k][1],lo[k][2],lo[k][3],hi[k][0],hi[k][1],hi[k][2],hi[k][3]}
    o[d0]=__builtin_amdgcn_mfma_f32_32x32x16_bf16(pa0,PK(0),o[d0],0,0,0);
    o[d0]=__builtin_amdgcn_mfma_f32_32x32x16_bf16(pa1,PK(1),o[d0],0,0,0);
    o[d0]=__builtin_amdgcn_mfma_f32_32x32x16_bf16(pa2,PK(2),o[d0],0,0,0);
    o[d0]=__builtin_amdgcn_mfma_f32_32x32x16_bf16(pa3,PK(3),o[d0],0,0,0);
    #undef PK
  }
}

#ifndef ATTN_STORE16
#define ATTN_STORE16(p,v) (*(u32x4*)(p)=(v))
#endif
template<int THRL> __device__ __forceinline__ void attn_unit(int b,int h,int qb,const bf16*Q,const bf16*__restrict__ K,const bf16*__restrict__ V,bf16*O,const float*KM,char*shm){
  const int tid=threadIdx.x,lane=tid&63,r32=lane&31,hi=lane>>5; const int wid=__builtin_amdgcn_readfirstlane(tid>>6);
  const long rowbase=(long)b*SEQ; const int q0=qb*QB;
  const bf16*Qw=Q+(rowbase+q0+wid*QBLK)*DM+h*D;
  const bf16*Kh=K+rowbase*DM+h*D,*Vh=V+rowbase*DM+h*D;
  const unsigned lds0=(unsigned)(uintptr_t)shm;
  float*wsf=(float*)(shm+LDS_WS)+wid*64;
  const bf16*ksrc=Kh+(long)lane*DM+wid*8;
  const bf16*vsrc=Vh+(long)(16*(wid&3)+(lane>>2))*DM+(wid>>2)*32+(lane&3)*8;
  const unsigned kdst=lds0+LDS_K+wid*1024, vdst=lds0+LDS_V+wid*1024;
  #define PHYS(t) (((t)<4)?(NT-4+(t)):((t)-4))
  #define DMA_K(t,slot) glds16(ksrc+(long)PHYS(t)*KVBLK*DM,(unsigned)__builtin_amdgcn_readfirstlane(kdst+(slot)))
  #define DMA_V(t,slot) glds16(vsrc+(long)PHYS(t)*KVBLK*DM,(unsigned)__builtin_amdgcn_readfirstlane(vdst+(slot)))
  const int vb0=(int)(lds0+LDS_V)+((lane>>4)&1)*32+(lane&3)*8+(4*hi+((lane&15)>>2))*64;
  const char*Kbase=shm+LDS_K; bf16x8 kf[8];
  const lds_cptr shm3=(lds_cptr)shm; const lds_cptr kp0=shm3+LDS_K+hi*1024+r32*16; const lds_cptr vp0=shm3+LDS_V+((lane>>4)&1)*32+(lane&3)*8+(4*hi+((lane&15)>>2))*64;
  const int NT=(q0+QB)/KVBLK;
  DMA_K(0,0);DMA_V(0,0);DMA_K(1,SLOTB);
  bf16x8 qr[4];
  #pragma unroll
  for(int d0=0;d0<4;++d0)qr[d0]=*reinterpret_cast<const bf16x8*>(&Qw[(long)r32*DM+d0*16+hi*8]);
  int selmask=(1<<qb)-1;
  if(qb>3){
    float gt[7];
    #pragma unroll
    for(int kb=0;kb<7;++kb){ float a=0.f;
      if(kb<qb){ const float*km=KM+(((long)b*NHEAD+h)*8+kb)*64+hi*8;
        #pragma unroll
        for(int d0=0;d0<4;++d0){ const f32x4_t k0=*reinterpret_cast<const f32x4_t*>(km+d0*16), k1=*reinterpret_cast<const f32x4_t*>(km+d0*16+4);
          a+=bf2f(qr[d0][0])*k0[0]+bf2f(qr[d0][1])*k0[1]+bf2f(qr[d0][2])*k0[2]+bf2f(qr[d0][3])*k0[3]+bf2f(qr[d0][4])*k1[0]+bf2f(qr[d0][5])*k1[1]+bf2f(qr[d0][6])*k1[2]+bf2f(qr[d0][7])*k1[3]; } }
      a+=__shfl_xor(a,32); gt[kb]=a; }
    selmask=0;
    #pragma unroll
    for(int kb=0;kb<7;++kb){ int rank=0;
      #pragma unroll
      for(int k2=0;k2<7;++k2){ if(k2!=kb&&k2<qb){ rank+=((gt[k2]>gt[kb])||(gt[k2]==gt[kb]&&k2<kb))?1:0; } }
      if(kb<qb&&rank<3)selmask|=(1<<kb); }
  }
  float mhat=0.f,l_reg=0.f;f32x16 o[2];o[0]=f32x16{};o[1]=f32x16{};const f32x16 zc=f32x16{};
  const int qrel=wid*QBLK+r32;
  #define CMASK(P0,P1,t) do{int jb_=(t); if(jb_<4)cmask(P0,P1,jb_,qrel,hi); else if(!((selmask>>((jb_-4)>>2))&1)){ _Pragma("unroll") for(int r_=0;r_<16;++r_){P0[r_]=-INFINITY;P1[r_]=-INFINITY;} } }while(0)
  bool resc=false;
  #define START(P0,P1) do{ const float rm=rowmax(P0,P1); resc=false; \
    { const float dl=rm; mhat=fadd_s(mhat,dl); \
      _Pragma("unroll") for(int r=0;r<16;++r){P0[r]=fsub_s(P0[r],dl);P1[r]=fsub_s(P1[r],dl);} \
      } \
    _Pragma("unroll") for(int r=0;r<16;++r)P0[r]=__builtin_amdgcn_exp2f(P0[r]); }while(0)
  #define RESC() do{ if(resc){ asm volatile("s_waitcnt lgkmcnt(0)":::"memory"); \
      _Pragma("unroll") for(int d_=0;d_<2;++d_) _Pragma("unroll") for(int r=0;r<16;++r)o[d_][r]*=wsf[crow(r,hi)]; } }while(0)
  f32x16 pA0,pA1,pB0,pB1;
  int sl_prev=0,sl_cur=0,sl_next=SLOTB;
  #define ROT() do{sl_prev=sl_cur;sl_cur=sl_next;sl_next=(sl_next==(NSLOT-1)*SLOTB)?0:sl_next+SLOTB;}while(0)
  DMA_K(2,2*SLOTB);
  WAIT_BAR(3);
  qkt(pA0,pA1,Kbase,qr,zc,r32,hi);asm volatile("s_nop 15\n\ts_nop 7":"+v"(pA0),"+v"(pA1));CMASK(pA0,pA1,0);
  START(pA0,pA1);
  _Pragma("unroll") for(int r=0;r<16;++r)pA1[r]=__builtin_amdgcn_exp2f(pA1[r]);
  WAIT_BAR(0);
  DMA_K(3,0);DMA_V(1,SLOTB);
  ROT();
  kload8(kf,kp0+sl_cur);
  WAIT_BAR(2);
  s16x4 vlo[8],vhi[8]; u32x4 pw0,pw1,pw2,pw3;
  #define PKW(P,B) cvtpk_s(P[B],P[B+1])
  #define PAF(k) __builtin_bit_cast(bf16x8,pw##k)
  #define VFR(i) (bf16x8){vlo[i][0],vlo[i][1],vlo[i][2],vlo[i][3],vhi[i][0],vhi[i][1],vhi[i][2],vhi[i][3]}
  #define PIN(x) asm volatile("":"+v"(x))
  #define MX3(a,b,c) __builtin_fmaxf(__builtin_fmaxf((a),(b)),(c))
  #define GAPA(MF,A0,A1,A2,A3,W0,W1,PW) do{ MF; sacc+=A0; sacc+=A1; sacc+=A2; sacc+=A3; PIN(sacc); W0; W1; PIN(PW); SBAR(); }while(0)
  #define EX(v) __builtin_amdgcn_exp2f(v)
  #define GAPB(MF,X,B) do{ MF; X[B]=EX(X[B]-mhat); X[B+1]=EX(X[B+1]-mhat); X[B+2]=EX(X[B+2]-mhat); X[B+3]=EX(X[B+3]-mhat); PIN(X); SBAR(); }while(0)
  #define VRD(i) do{ vlo[i]=vtr(vp_+(((i)>>2)*4096+((i)&3)*1024)); vhi[i]=vtr(vp_+(((i)>>2)*4096+((i)&3)*1024+512)); }while(0)
  #define KRD(G,j) do{ if(G){ kload2(kf,kp0+sl_next,j); SBAR(); } }while(0)
  #define STEP(C0,C1,P0,P1,t,GK,GV,GL) do{ SBAR(); \
    const lds_cptr vp_=vp0+sl_prev; \
    VRD(0); SBAR(); float sacc=(P0[0]+P0[1]); \
    GAPA(C0=__builtin_amdgcn_mfma_f32_32x32x16_bf16(kf[0],qr[0],zc,0,0,0), P0[2],P0[3],P0[4],P0[5],     pw0[0]=PKW(P0,0), pw0[1]=PKW(P0,2), pw0); \
    VRD(4); SBAR(); GAPA(C1=__builtin_amdgcn_mfma_f32_32x32x16_bf16(kf[1],qr[0],zc,0,0,0), P0[6],P0[7],P0[8],P0[9],     pw0[2]=PKW(P0,4), pw0[3]=PKW(P0,6), pw0); \
    VRD(1); SBAR(); GAPA(C0=__builtin_amdgcn_mfma_f32_32x32x16_bf16(kf[2],qr[1],C0,0,0,0),   P0[10],P0[11],P0[12],P0[13], pw1[0]=PKW(P0,8), pw1[1]=PKW(P0,10), pw1); \
    VRD(5); SBAR(); GAPA(C1=__builtin_amdgcn_mfma_f32_32x32x16_bf16(kf[3],qr[1],C1,0,0,0),   P0[14],P0[15],P1[0],P1[1],   pw1[2]=PKW(P0,12),pw1[3]=PKW(P0,14), pw1); \
    VRD(2); SBAR(); GAPA(C0=__builtin_amdgcn_mfma_f32_32x32x16_bf16(kf[4],qr[2],C0,0,0,0),   P1[2],P1[3],P1[4],P1[5],     pw2[0]=PKW(P1,0), pw2[1]=PKW(P1,2), pw2); \
    VRD(6); SBAR(); GAPA(C1=__builtin_amdgcn_mfma_f32_32x32x16_bf16(kf[5],qr[2],C1,0,0,0),   P1[6],P1[7],P1[8],P1[9],     pw2[2]=PKW(P1,4), pw2[3]=PKW(P1,6), pw2); \
    VRD(3); SBAR(); GAPA(C0=__builtin_amdgcn_mfma_f32_32x32x16_bf16(kf[6],qr[3],C0,0,0,0),   P1[10],P1[11],P1[12],P1[13], pw3[0]=PKW(P1,8), pw3[1]=PKW(P1,10), pw3); \
    VRD(7); SBAR(); GAPA(C1=__builtin_amdgcn_mfma_f32_32x32x16_bf16(kf[7],qr[3],C1,0,0,0),   P1[14],P1[15],0.f,0.f,       pw3[2]=PKW(P1,12),pw3[3]=PKW(P1,14), pw3); \
    l_reg+=sacc; \
    if(GK){DMA_K((t)+3,sl_cur);} if(GV){DMA_V((t)+1,sl_next);} \
    CMASK(C0,C1,t); \
    { float a=MX3(C0[0],C0[1],C1[0]),b=MX3(C0[2],C0[3],C1[1]); a=MX3(a,C1[2],C1[3]); \
      _Pragma("unroll") for(int r=4;r<16;r+=4){a=MX3(a,C0[r],C0[r+1]);b=MX3(b,C0[r+2],C0[r+3]);a=MX3(a,C1[r],C1[r+1]);b=MX3(b,C1[r+2],C1[r+3]);} \
      float rm=__builtin_fmaxf(a,b); { auto rr=__builtin_amdgcn_permlane32_swap(__float_as_uint(rm),__float_as_uint(rm),false,false); rm=__builtin_fmaxf(__uint_as_float(rr[0]),__uint_as_float(rr[1])); } \
      rm-=mhat; resc=false; \
      if(__builtin_expect(__any(rm>(float)THRL),0)){ const float dl=__builtin_fmaxf(rm,0.f); mhat+=dl; \
        const float f=__builtin_amdgcn_exp2f(-dl); l_reg*=f; if(hi==0)wsf[r32]=f; resc=true; } } \
    SBAR(); \
    GAPB(o[0]=__builtin_amdgcn_mfma_f32_32x32x16_bf16(PAF(0),VFR(0),o[0],0,0,0), C0,0); \
    GAPB(o[1]=__builtin_amdgcn_mfma_f32_32x32x16_bf16(PAF(0),VFR(4),o[1],0,0,0), C0,4); \
    KRD(GL,0); GAPB(o[0]=__builtin_amdgcn_mfma_f32_32x32x16_bf16(PAF(1),VFR(1),o[0],0,0,0), C0,8); \
    KRD(GL,1); GAPB(o[1]=__builtin_amdgcn_mfma_f32_32x32x16_bf16(PAF(1),VFR(5),o[1],0,0,0), C0,12); \
    KRD(GL,2); GAPB(o[0]=__builtin_amdgcn_mfma_f32_32x32x16_bf16(PAF(2),VFR(2),o[0],0,0,0), C1,0); \
    KRD(GL,3); GAPB(o[1]=__builtin_amdgcn_mfma_f32_32x32x16_bf16(PAF(2),VFR(6),o[1],0,0,0), C1,4); \
    GAPB(o[0]=__builtin_amdgcn_mfma_f32_32x32x16_bf16(PAF(3),VFR(3),o[0],0,0,0), C1,8); \
    GAPB(o[1]=__builtin_amdgcn_mfma_f32_32x32x16_bf16(PAF(3),VFR(7),o[1],0,0,0), C1,12); \
    }while(0)
  int t=1;
  #undef CMASK
  #define CMASK(P0,P1,t) do{int jb_=(t); if(jb_<4)cmask(P0,P1,jb_,qrel,hi); else if(!((selmask>>((jb_-4)>>2))&1)){ _Pragma("unroll") for(int r_=0;r_<16;++r_){P0[r_]=-INFINITY;P1[r_]=-INFINITY;} } }while(0)
  #define ENDW(tt) do{ if((tt)+3<NT){WAIT_BAR(2);} else if((tt)+2<NT){WAIT_BAR(1);} else {WAIT_BAR(0);} }while(0)
  for(;t+1<NT;t+=2){
    STEP(pB0,pB1,pA0,pA1,t,(t+3<NT),(t+1<NT),(t+1<NT));       ENDW(t);   RESC(); ROT();
    STEP(pA0,pA1,pB0,pB1,t+1,(t+4<NT),(t+2<NT),(t+2<NT));     ENDW(t+1); RESC(); ROT();
  }
  STEP(pB0,pB1,pA0,pA1,NT-1,false,false,false); RESC();
  { float sacc=pB0[0]+pB0[1]; _Pragma("unroll") for(int r=2;r<16;++r)sacc+=pB0[r]; _Pragma("unroll") for(int r=0;r<16;++r)sacc+=pB1[r]; l_reg+=sacc;
    pw0=(u32x4){PKW(pB0,0),PKW(pB0,2),PKW(pB0,4),PKW(pB0,6)};pw1=(u32x4){PKW(pB0,8),PKW(pB0,10),PKW(pB0,12),PKW(pB0,14)};pw2=(u32x4){PKW(pB1,0),PKW(pB1,2),PKW(pB1,4),PKW(pB1,6)};pw3=(u32x4){PKW(pB1,8),PKW(pB1,10),PKW(pB1,12),PKW(pB1,14)};
    SBAR(); pv(o,vb0+sl_cur,PAF(0),PAF(1),PAF(2),PAF(3)); }
  #undef PKW
  #undef PAF
  #undef VFR
  #undef PIN
  #undef MX3
  #undef GAPA
  #undef GAPB
  #undef EX
  #undef VRD
  #undef KRD
  #undef STEP
  #undef ENDW
  {auto rr=__builtin_amdgcn_permlane32_swap(__float_as_uint(l_reg),__float_as_uint(l_reg),false,false);l_reg=__uint_as_float(rr[0])+__uint_as_float(rr[1]);}
  if(hi==0)wsf[32+r32]=l_reg;asm volatile("s_waitcnt lgkmcnt(0)":::"memory");
  float rli[16];
  #pragma unroll
  for(int r=0;r<16;++r)rli[r]=__builtin_amdgcn_rcpf(wsf[32+crow(r,hi)]);
  bf16*Ow=O+(rowbase+q0+wid*QBLK)*DM+h*D;
  { bf16*stg=(bf16*)(shm+LDS_OST)+wid*2048;
    #pragma unroll
    for(int r=0;r<16;++r){const int orow=crow(r,hi);
      #pragma unroll
      for(int d0=0;d0<2;++d0)stg[orow*64+d0*32+r32]=__float2bfloat16(o[d0][r]*rli[r]);}
    asm volatile("s_waitcnt lgkmcnt(0)":::"memory");
    #pragma unroll
    for(int i=0;i<4;++i){const int row=i*8+(lane>>3),ch=lane&7; const u32x4 v=*(const u32x4*)(stg+row*64+ch*8); ATTN_STORE16(Ow+(long)row*DM+ch*8,v);} }
  asm volatile("s_waitcnt lgkmcnt(0)\n\ts_barrier":::"memory");
  #undef DMA_K
  #undef PHYS
  #undef DMA_V
  #undef CMASK
  #undef START
  #undef RESC
  #undef ROT
}
constexpr int ATTN_LDS_BYTES=LDS_BYTES;
struct AttnTensors { const bf16* Q; const bf16* K; const bf16* V; bf16* O; const float* KM; };
struct AttnUnit { int bh; int qb; };
struct StaticOrder {
  int vcu,G;
  __device__ __forceinline__ explicit StaticOrder(int grid,int block):vcu((grid%8==0)?(block%8)*(grid/8)+block/8:block),G(grid){}
  __device__ __forceinline__ bool next(int i,AttnUnit&u)const{ const int idx=i*G+vcu; if(idx>=1024)return false; const int v=idx&255,j=idx>>8; u.bh=v>>1;
    const int s=(v&1); u.qb=(j==0)?s:(j==1)?7-s:(j==2)?3-s:4+s; return true; }
  __device__ __forceinline__ void a_ready(const AttnUnit&)const{}
  __device__ __forceinline__ void done(const AttnUnit&)const{}
};
template<class Sched,int THRL=8> __device__ __forceinline__ void attn_phase(char*lds,const AttnTensors&T,const Sched&S){
  AttnUnit u;
  for(int i=0;S.next(i,u);++i){ S.a_ready(u); attn_unit<THRL>(u.bh/NHEAD,u.bh%NHEAD,u.qb,T.Q,T.K,T.V,T.O,T.KM,lds); S.done(u); }
}
#undef SBAR
#undef WAIT_BAR
}
struct Args { const float* in[29]; float* out; unsigned char* ws; int ph_lo, ph_hi, li, pad; };
typedef const __attribute__((address_space(4))) Args* ArgsP;
__device__ __forceinline__ ArgsP fresh_args() { ArgsP p = (ArgsP)__builtin_amdgcn_kernarg_segment_ptr(); asm volatile("" : "+s"(p)); return p; }

struct Frame {
    LAS unsigned char* lds;
    volatile LAS unsigned* MISC;
    gu32* ctl;
    int tid, lane, wave, vcu, G;
};

__device__ __forceinline__ void conv_item(const float* W, int N, bf16_t* WT, int Kd, int dst_row0, int k0, int n0, LAS float* scr, int lane) {
#pragma unroll 8
    for (int i = 0; i < 32; ++i) { const int kk = 2 * i + (lane >> 5); scr[kk * 33 + (lane & 31)] = W[(size_t)(k0 + kk) * N + n0 + (lane & 31)]; }
    LDS_WAIT(); asm volatile("" ::: "memory");
    const int c = lane & 7;
#pragma unroll
    for (int j = 0; j < 4; ++j) { const int n = (lane >> 3) + 8 * j; const LAS float* s = scr + (8 * c) * 33 + n;
        u32x4 o; o.x = pk2(s[0 * 33], s[1 * 33]); o.y = pk2(s[2 * 33], s[3 * 33]); o.z = pk2(s[4 * 33], s[5 * 33]); o.w = pk2(s[6 * 33], s[7 * 33]);
        *(u32x4*)(WT + (size_t)(dst_row0 + n) * Kd + k0 + 8 * c) = o; }
    LDS_WAIT(); asm volatile("" ::: "memory");
}
__device__ __forceinline__ void conv_moe_layer(const Frame& F, ArgsP a, int layer, bf16_t* GU, bf16_t* DN, LAS float* scr) {
    const int gw = F.vcu * NWAVES + F.wave, NGW = F.G * NWAVES;
    constexpr int PER_E = 384, NIT = 65 * PER_E;
    for (int it = gw; it < NIT; it += NGW) {
        const int e = it / PER_E, r = it % PER_E, which = r >> 7, q = r & 127;
        const float* src;
        if (e < 64) src = a->in[22 + which] + (size_t)(layer * 64 + e) * (1024 * 256);
        else src = a->in[25 + which] + (size_t)layer * (1024 * 256);
        if (which < 2) { const int kb = q >> 3, nb = q & 7, n0 = nb * 32;
            conv_item(src, 256, GU, 1024, e * 512 + (n0 >> 7) * 256 + which * 128 + (n0 & 127), kb * 64, n0, scr, F.lane);
        } else { const int kb = q >> 5, nb = q & 31, n0 = nb * 32;
            conv_item(src, 1024, DN, 256, e * 1024 + n0, kb * 64, n0, scr, F.lane); }
    }
}
__device__ __forceinline__ void conv_dense(const Frame& F, const float* W, int K, int N, bf16_t* WT, LAS float* scr) {
    const int gw = F.vcu * NWAVES + F.wave, NGW = F.G * NWAVES;
    const int nblk = N / 32, nit = (K / 64) * nblk;
    for (int it = gw; it < nit; it += NGW) { const int kb = it / nblk, nb = it % nblk; conv_item(W, N, WT, K, nb * 32, kb * 64, nb * 32, scr, F.lane); }
}

__device__ __forceinline__ void row_load(const float* row, int lane, float (&v)[16]) {
#pragma unroll
    for (int jj = 0; jj < 2; ++jj) { const f32x4 a = *(const f32x4*)(row + 8 * lane + 512 * jj), b = *(const f32x4*)(row + 8 * lane + 512 * jj + 4);
#pragma unroll
        for (int j = 0; j < 4; ++j) { v[8 * jj + j] = a[j]; v[8 * jj + 4 + j] = b[j]; } }
}
__device__ __forceinline__ void row_store(float* row, int lane, const float (&v)[16]) {
#pragma unroll
    for (int jj = 0; jj < 2; ++jj) { *(f32x4*)(row + 8 * lane + 512 * jj) = (f32x4){v[8 * jj], v[8 * jj + 1], v[8 * jj + 2], v[8 * jj + 3]}; *(f32x4*)(row + 8 * lane + 512 * jj + 4) = (f32x4){v[8 * jj + 4], v[8 * jj + 5], v[8 * jj + 6], v[8 * jj + 7]}; }
}
__device__ __forceinline__ float row_rstd(const float (&v)[16]) {
    float s = 0.f;
#pragma unroll
    for (int j = 0; j < 16; ++j) s += v[j] * v[j];
    return rsqrtf(wave_sum(s) * (1.0f / D) + RMS_EPS);
}
__device__ __forceinline__ void row_mod(const float (&v)[16], float rstd, const float* g, const float* shift, const float* scale, int lane, float (&h)[16]) {
    float gg[16], sh[16], sc[16];
    row_load(g, lane, gg); row_load(shift, lane, sh); row_load(scale, lane, sc);
#pragma unroll
    for (int j = 0; j < 16; ++j) h[j] = (v[j] * rstd * gg[j]) * (1.0f + sc[j]) + sh[j];
}
__device__ __forceinline__ void row_store_bf16(bf16_t* row, int lane, const float (&h)[16]) {
#pragma unroll
    for (int jj = 0; jj < 2; ++jj) { u32x4 w; w.x = pk2(h[8 * jj], h[8 * jj + 1]); w.y = pk2(h[8 * jj + 2], h[8 * jj + 3]); w.z = pk2(h[8 * jj + 4], h[8 * jj + 5]); w.w = pk2(h[8 * jj + 6], h[8 * jj + 7]);
        *(u32x4*)(row + 8 * lane + 512 * jj) = w; }
}
__device__ __forceinline__ void row_add_y(float (&v)[16], const bf16_t* y, const float* gate, int lane) {
    float s[16];
#pragma unroll
    for (int j = 0; j < 16; ++j) s[j] = 0.f;
#pragma unroll
    for (int k = 0; k < TOPK; ++k)
#pragma unroll
        for (int jj = 0; jj < 2; ++jj) { const u32x4 w = *(const u32x4*)(y + (size_t)k * D + 8 * lane + 512 * jj);
            s[8 * jj + 0] += bf_lo(w.x); s[8 * jj + 1] += bf_hi(w.x); s[8 * jj + 2] += bf_lo(w.y); s[8 * jj + 3] += bf_hi(w.y);
            s[8 * jj + 4] += bf_lo(w.z); s[8 * jj + 5] += bf_hi(w.z); s[8 * jj + 6] += bf_lo(w.w); s[8 * jj + 7] += bf_hi(w.w); }
    float gg[16]; row_load(gate, lane, gg);
#pragma unroll
    for (int j = 0; j < 16; ++j) v[j] += gg[j] * s[j];
}

__device__ __forceinline__ void phase_p0(const Frame& F, ArgsP a) {
    unsigned char* ws = a->ws;
    if ((int)blockIdx.x < 224) {
        LAS float* sc = (LAS float*)F.lds;
        LAS float* red = (LAS float*)(F.lds + 32768);
        const float* c = a->in[1];
        for (int i = F.tid; i < 8 * 1024; i += NTHREADS) sc[i] = silu_f(c[i]);
        __syncthreads();
        const int cg = blockIdx.x;
        const float* W; const float* bias; float* out; int N, n0;
        if (cg < 96) { W = a->in[2]; bias = a->in[3]; out = (float*)(ws + WS_MOD); N = 6144; n0 = cg * 64; }
        else if (cg < 192) { W = a->in[2] + (size_t)1024 * 6144; bias = a->in[3] + 6144; out = (float*)(ws + WS_MOD) + MOD_L; N = 6144; n0 = (cg - 96) * 64; }
        else { W = a->in[14]; bias = a->in[15]; out = (float*)(ws + WS_MOD) + 2 * MOD_L; N = 2048; n0 = (cg - 192) * 64; }
        float acc[8];
#pragma unroll
        for (int b = 0; b < 8; ++b) acc[b] = 0.f;
        const int k0 = F.wave * 128;
#pragma unroll 4
        for (int kk = 0; kk < 128; kk += 4) {
            float w[4];
#pragma unroll
            for (int i = 0; i < 4; ++i) w[i] = W[(size_t)(k0 + kk + i) * N + n0 + F.lane];
#pragma unroll
            for (int b = 0; b < 8; ++b) { const f32x4 s = *(const LAS f32x4*)(sc + b * 1024 + k0 + kk); acc[b] += s[0] * w[0]; acc[b] += s[1] * w[1]; acc[b] += s[2] * w[2]; acc[b] += s[3] * w[3]; }
        }
#pragma unroll
        for (int b = 0; b < 8; ++b) red[(F.wave * 8 + b) * 64 + F.lane] = acc[b];
        __syncthreads();
        { const int b = F.tid >> 6, l = F.tid & 63; float s = 0.f;
#pragma unroll
            for (int w = 0; w < 8; ++w) s += red[(w * 8 + b) * 64 + l];
            out[(size_t)b * N + n0 + l] = s + bias[n0 + l]; }
        __syncthreads();
    }
    LAS float* scr = (LAS float*)(F.lds + F.wave * 16384);
    conv_dense(F, a->in[6], 1024, 4096, (bf16_t*)(ws + WS_WIN_T), scr);
    conv_dense(F, a->in[12], 2048, 1024, (bf16_t*)(ws + WS_WOUT_T), scr);
    conv_dense(F, a->in[18], 1024, 1024, (bf16_t*)(ws + WS_WQKV_T), scr);
    conv_dense(F, a->in[16], 1024, 1024, (bf16_t*)(ws + WS_WQKV_T) + (size_t)1024 * 1024, scr);
    conv_dense(F, a->in[17], 1024, 1024, (bf16_t*)(ws + WS_WQKV_T) + (size_t)2048 * 1024, scr);
    conv_dense(F, a->in[19], 1024, 1024, (bf16_t*)(ws + WS_WO_T), scr);
    conv_moe_layer(F, a, 0, (bf16_t*)(ws + WS_GU), (bf16_t*)(ws + WS_DN), scr);
    { const float* wsp = a->in[10]; bf16_t* o = (bf16_t*)(ws + WS_WSP);
      for (int i = blockIdx.x * NTHREADS + F.tid; i < 8 * 128 * 128; i += F.G * NTHREADS) { const int t = (i >> 7) & 127, s = i & 127; o[i] = (bf16_t)(s <= t ? f2bf(wsp[i]) : 0u); } }
}

__device__ __forceinline__ void phase_p1(const Frame& F, ArgsP a) {
    const int gw = blockIdx.x * NWAVES + F.wave, NGW = F.G * NWAVES;
    const float* mod = (const float*)(a->ws + WS_MOD);
    bf16_t* hA = (bf16_t*)(a->ws + WS_SCR);
    for (int m = gw; m < T; m += NGW) {
        const int b = m / SEQ; float v[16], h[16];
        row_load(a->in[0] + (size_t)m * D, F.lane, v);
        const float rstd = row_rstd(v);
        row_mod(v, rstd, a->in[4], mod + (size_t)b * 6144, mod + (size_t)b * 6144 + 1024, F.lane, h);
        row_store_bf16(hA + (size_t)m * D, F.lane, h);
    }
}

__device__ __forceinline__ void phase_p3(const Frame& F, ArgsP a) {
    bf16_t* U = (bf16_t*)(a->ws + WS_SCR + 64 * MiB); const bf16_t* VT = (const bf16_t*)(a->ws + WS_SCR + 128 * MiB);
    const bf16_t* Wsp = (const bf16_t*)(a->ws + WS_WSP); const float* vpart = (const float*)(a->ws + WS_VPART);
    const float* lng = a->in[8]; const float* lnb = a->in[9]; const float* bsp = a->in[11];
    LAS float* mu = (LAS float*)F.lds; LAS float* rs = mu + 128;
    const int fr = F.lane & 15, fq = F.lane >> 4;
    for (int item = blockIdx.x; item < 256; item += F.G) {
        const int chunk = item >> 1, g0 = (item & 1) * 4;
        __syncthreads();
        if (F.tid < 128) { const float* p = vpart + (size_t)(chunk * 128 + F.tid) * 64; float s1 = 0.f, s2 = 0.f;
            for (int j = 0; j < 32; ++j) { s1 += p[2 * j]; s2 += p[2 * j + 1]; }
            const float mean = s1 * (1.0f / AW), var = s2 * (1.0f / AW) - mean * mean; mu[F.tid] = mean; rs[F.tid] = rsqrtf(var + LN_EPS); }
        __syncthreads();
        for (int gi = 0; gi < 4; ++gi) {
            const int g = g0 + gi;
            f32x4 acc[2][8];
#pragma unroll
            for (int dt = 0; dt < 2; ++dt)
#pragma unroll
                for (int tt = 0; tt < 8; ++tt) acc[dt][tt] = (f32x4){0.f, 0.f, 0.f, 0.f};
            bf16x8 af[2][4];
#pragma unroll
            for (int dt = 0; dt < 2; ++dt) {
                const int col = g * 256 + 32 * F.wave + 16 * dt + fr; const float lg = lng[col], lb = lnb[col];
#pragma unroll
                for (int ks = 0; ks < 4; ++ks) {
                    const int s0 = 32 * ks + 8 * fq;
                    const u32x4 raw = *(const u32x4*)(VT + ((size_t)chunk * AW + col) * 128 + s0);
                    const f32x4 m0 = *(const LAS f32x4*)(mu + s0), m1 = *(const LAS f32x4*)(mu + s0 + 4), r0 = *(const LAS f32x4*)(rs + s0), r1 = *(const LAS f32x4*)(rs + s0 + 4);
                    float x[8] = {bf_lo(raw.x), bf_hi(raw.x), bf_lo(raw.y), bf_hi(raw.y), bf_lo(raw.z), bf_hi(raw.z), bf_lo(raw.w), bf_hi(raw.w)};
#pragma unroll
                    for (int j = 0; j < 4; ++j) { x[j] = (x[j] - m0[j]) * r0[j] * lg + lb; x[4 + j] = (x[4 + j] - m1[j]) * r1[j] * lg + lb; }
                    u32x4 o; o.x = pk2(x[0], x[1]); o.y = pk2(x[2], x[3]); o.z = pk2(x[4], x[5]); o.w = pk2(x[6], x[7]);
                    af[dt][ks] = __builtin_bit_cast(bf16x8, o);
                }
            }
#pragma unroll
            for (int tt = 0; tt < 8; ++tt)
#pragma unroll
                for (int ks = 0; ks < 4; ++ks) if (2 * ks <= tt) {
                    const bf16x8 bw = *(const bf16x8*)(Wsp + ((size_t)g * 128 + 16 * tt + fr) * 128 + 32 * ks + 8 * fq);
#pragma unroll
                    for (int dt = 0; dt < 2; ++dt) acc[dt][tt] = __builtin_amdgcn_mfma_f32_16x16x32_bf16(af[dt][ks], bw, acc[dt][tt], 0, 0, 0);
                }
#pragma unroll
            for (int tt = 0; tt < 8; ++tt) {
                const int t = 16 * tt + fr; const float bs = bsp[g * 128 + t];
#pragma unroll
                for (int dt = 0; dt < 2; ++dt) {
                    bf16_t* up = U + (size_t)(chunk * 128 + t) * AW + g * 256 + 32 * F.wave + 16 * dt + 4 * fq;
                    const u32x2 uu = *(const u32x2*)up; const f32x4 sv = acc[dt][tt] + bs;
                    u32x2 o; o.x = pk2(bf_lo(uu.x) * sv[0], bf_hi(uu.x) * sv[1]); o.y = pk2(bf_lo(uu.y) * sv[2], bf_hi(uu.y) * sv[3]);
                    *(u32x2*)up = o;
                }
            }
        }
    }
}

__device__ __forceinline__ void phase_router(const Frame& F, ArgsP a, int layer) {
    const float* X = a->out; bf16_t* hA = (bf16_t*)(a->ws + WS_SCR);
    const float* mod = (const float*)(a->ws + WS_MOD) + (size_t)layer * MOD_L;
    const float* nw = a->in[5] + layer * D; const float* Wr = a->in[20] + (size_t)layer * D * NE; const float* eb = a->in[21] + layer * NE;
    int* toklist = (int*)(a->ws + WS_TOKLIST); float* wlist = (float*)(a->ws + WS_WLIST);
    unsigned* cnt = (unsigned*)(a->ws + WS_CTL) + CW_CNT + layer * 64;
    LAS float* xs = (LAS float*)F.lds + F.wave * 4096;
    LAS int* sel_e = (LAS int*)(F.lds + LDS_AUX); LAS float* sel_w = (LAS float*)(sel_e + 512); LAS int* sel_li = (LAS int*)(sel_w + 512);
    LAS int* hist = sel_li + 512; LAS int* gbase = hist + 64;
    for (int grp = blockIdx.x; grp < T / 64; grp += F.G) {
        __syncthreads();
        if (F.tid < 64) hist[F.tid] = 0;
        __syncthreads();
        for (int rd = 0; rd < 2; ++rd) {
            const int tl0 = rd * 32 + F.wave * 4;
#pragma unroll 1
            for (int j = 0; j < 4; ++j) {
                const int t = grp * 64 + tl0 + j, b = t / SEQ; float v[16], h[16];
                row_load(X + (size_t)t * D, F.lane, v);
                const float rstd = row_rstd(v);
                row_mod(v, rstd, nw, mod + (size_t)b * 6144 + 3072, mod + (size_t)b * 6144 + 4096, F.lane, h);
                row_store_bf16(hA + (size_t)t * D, F.lane, h);
#pragma unroll
                for (int jj = 0; jj < 2; ++jj) { *(LAS f32x4*)(xs + j * 1024 + 8 * F.lane + 512 * jj) = (f32x4){h[8 * jj], h[8 * jj + 1], h[8 * jj + 2], h[8 * jj + 3]};
                    *(LAS f32x4*)(xs + j * 1024 + 8 * F.lane + 512 * jj + 4) = (f32x4){h[8 * jj + 4], h[8 * jj + 5], h[8 * jj + 6], h[8 * jj + 7]}; }
            }
            LDS_WAIT(); asm volatile("" ::: "memory");
            float lg[4] = {0.f, 0.f, 0.f, 0.f};
#pragma unroll 2
            for (int d0 = 0; d0 < D; d0 += 4) {
                float w[4];
#pragma unroll
                for (int i = 0; i < 4; ++i) w[i] = Wr[(size_t)(d0 + i) * NE + F.lane];
#pragma unroll
                for (int j = 0; j < 4; ++j) { const f32x4 xv = *(const LAS f32x4*)(xs + j * 1024 + d0); lg[j] += xv[0] * w[0]; lg[j] += xv[1] * w[1]; lg[j] += xv[2] * w[2]; lg[j] += xv[3] * w[3]; }
            }
            const float bias = eb[F.lane];
#pragma unroll
            for (int j = 0; j < 4; ++j) {
                const float score = 1.0f / (1.0f + __expf(-lg[j])), choice = score + bias;
                float m1 = choice; m1 = fmaxf(m1, __shfl_xor(m1, 1)); m1 = fmaxf(m1, __shfl_xor(m1, 2)); m1 = fmaxf(m1, __shfl_xor(m1, 4));
                int idx = (choice == m1) ? (F.lane & 7) : 8; idx = min(idx, __shfl_xor(idx, 1)); idx = min(idx, __shfl_xor(idx, 2)); idx = min(idx, __shfl_xor(idx, 4));
                float m2 = ((F.lane & 7) == idx) ? -INFINITY : choice; m2 = fmaxf(m2, __shfl_xor(m2, 1)); m2 = fmaxf(m2, __shfl_xor(m2, 2)); m2 = fmaxf(m2, __shfl_xor(m2, 4));
                const float gs = m1 + m2; const int g = F.lane >> 3;
                int grank = 0;
#pragma unroll
                for (int g2 = 0; g2 < 8; ++g2) { const float o = __shfl(gs, g2 * 8); grank += ((o > gs) || (o == gs && g2 < g)) ? 1 : 0; }
                const float cm = (grank < 4) ? choice : -1e30f;
                int rank = 0;
#pragma unroll
                for (int e2 = 0; e2 < 64; ++e2) { const float o = __shfl(cm, e2); rank += ((o > cm) || (o == cm && e2 < F.lane)) ? 1 : 0; }
                const bool sel = rank < TOPK;
                const float wsum = wave_sum(sel ? score : 0.f);
                const float w = score / wsum * ROUTED_SCALE;
                const unsigned long long bal = __ballot(sel);
                if (sel) { const int k = __popcll(bal & ((1ull << F.lane) - 1ull)); const int tl = tl0 + j;
                    sel_e[tl * 8 + k] = F.lane; sel_w[tl * 8 + k] = w; sel_li[tl * 8 + k] = __hip_atomic_fetch_add(&hist[F.lane], 1, __ATOMIC_RELAXED, __HIP_MEMORY_SCOPE_WORKGROUP); }
            }
        }
        __syncthreads();
        if (F.tid < 64) gbase[F.tid] = (int)__hip_atomic_fetch_add(cnt + F.tid, (unsigned)hist[F.tid], RLX_AGENT);
        __syncthreads();
        { const int p = F.tid, e = sel_e[p], pos = gbase[e] + sel_li[p];
          toklist[(size_t)e * CAP + pos] = (grp * 64 + (p >> 3)) * 8 + (p & 7); wlist[(size_t)e * CAP + pos] = sel_w[p]; }
    }
}

__device__ __forceinline__ void moe_tables(const Frame& F, ArgsP a, int layer, LAS int* cntl, LAS int* tb) {
    const unsigned* cnt = (const unsigned*)(a->ws + WS_CTL) + CW_CNT + layer * 64;
    __syncthreads();
    if (F.tid < 64) cntl[F.tid] = (int)__hip_atomic_load(cnt + F.tid, RLX_AGENT);
    __syncthreads();
    if (F.tid == 0) { int s = 0; for (int e = 0; e < 64; ++e) { tb[e] = s; s += (cntl[e] + 255) >> 8; } tb[64] = s; tb[65] = s + T / 256; }
    __syncthreads();
}

__device__ __forceinline__ void phase_p8(const Frame& F, ArgsP a) {
    const int gw = blockIdx.x * NWAVES + F.wave, NGW = F.G * NWAVES;
    const float* mod0 = (const float*)(a->ws + WS_MOD); const float* mod1 = mod0 + MOD_L; const float* modkv = mod0 + 2 * MOD_L;
    float* X = a->out; const bf16_t* Y = (const bf16_t*)(a->ws + WS_SCR); bf16_t* hB = (bf16_t*)(a->ws + WS_H);
    for (int m = gw; m < T; m += NGW) {
        const int b = m / SEQ; float v[16], h[16];
        row_load(X + (size_t)m * D, F.lane, v);
        row_add_y(v, Y + (size_t)m * TOPK * D, mod0 + (size_t)b * 6144 + 5120, F.lane);
        row_store(X + (size_t)m * D, F.lane, v);
        const float rstd = row_rstd(v);
        row_mod(v, rstd, a->in[4] + D, mod1 + (size_t)b * 6144, mod1 + (size_t)b * 6144 + 1024, F.lane, h);
        row_store_bf16(hB + (size_t)m * D, F.lane, h);
        row_mod(v, rstd, a->in[13], modkv + (size_t)b * 2048, modkv + (size_t)b * 2048 + 1024, F.lane, h);
        row_store_bf16(hB + (size_t)(T + m) * D, F.lane, h);
    }
    LAS float* scr = (LAS float*)(F.lds + F.wave * 16384);
    conv_moe_layer(F, a, 1, (bf16_t*)(a->ws + WS_GU), (bf16_t*)(a->ws + WS_DN), scr);
}

__device__ __forceinline__ void phase_final(const Frame& F, ArgsP a) {
    const int gw = blockIdx.x * NWAVES + F.wave, NGW = F.G * NWAVES;
    const float* mod1 = (const float*)(a->ws + WS_MOD) + MOD_L;
    float* X = a->out; const bf16_t* Y = (const bf16_t*)(a->ws + WS_SCR);
    for (int m = gw; m < T; m += NGW) {
        const int b = m / SEQ; float v[16], g[16];
        row_load(X + (size_t)m * D, F.lane, v);
        row_add_y(v, Y + (size_t)m * TOPK * D, mod1 + (size_t)b * 6144 + 5120, F.lane);
        const float rstd = row_rstd(v);
        row_load(a->in[28], F.lane, g);
#pragma unroll
        for (int j = 0; j < 16; ++j) v[j] = v[j] * rstd * g[j];
        row_store(X + (size_t)m * D, F.lane, v);
    }
}
#ifndef MK_N_LAUNCHES
#define MK_N_LAUNCHES 1
#endif
constexpr int N_PHASES = 16;
#ifndef REF_MASK
#define REF_MASK 0u
#endif
#define GEMM_RUN(k, GATHER, A, B, K, S, E) do { if ((REF_MASK >> (k)) & 1u) gemm_ref(A, B, K, S, E); else pg8::gemm_phase<GATHER>(F.lds, A, B, K, S, E); } while (0)
constexpr int N_LAUNCHES = MK_N_LAUNCHES;

__global__ void __launch_bounds__(NTHREADS, 2) yoco_fwd(Args args) {
    extern __shared__ __attribute__((aligned(16))) unsigned char lds[];
    Frame F;
    F.lds = (LAS unsigned char*)lds;
    F.MISC = (volatile LAS unsigned*)(F.lds + MISC_OFF);
    F.tid = threadIdx.x; F.lane = F.tid & 63; F.wave = __builtin_amdgcn_readfirstlane(F.tid >> 6);
    F.G = gridDim.x; { const int bx = blockIdx.x; F.vcu = (F.G % 8 == 0) ? (bx % 8) * (F.G / 8) + bx / 8 : bx; }
    F.ctl = (gu32*)(args.ws + WS_CTL);
    for (int u = F.tid; u < (LDS_BYTES - LDSCTL_OFF) / 4; u += NTHREADS) ((LAS unsigned*)(F.lds + LDSCTL_OFF))[u] = 0u;
    __syncthreads();
    XcdBarrier bar; bar.bar = (unsigned*)(F.ctl + CW_BAR); bar.x = 0; bar.st = nullptr;
    if (N_LAUNCHES == 1) bar = xcd_barrier_post((unsigned*)(F.ctl + CW_BAR), F.MISC + 8);
#define GRID_BAR() do { if (N_LAUNCHES == 1) xcd_barrier(bar); } while (0)
    const int lo = args.ph_lo, hi = args.ph_hi;
#ifndef PH_MASK
#define PH_MASK 0xFFFFFFFFu
#endif
#define PHON(k) ((PH_MASK >> (k)) & 1u)
#define IN(k) (lo <= (k) && (k) < hi && PHON((k) >= 12 ? (k) - 7 : (k)))
#define SEAM(k) do { if (IN(k) && IN((k) + 1)) GRID_BAR(); } while (0)
    LAS int* cntl = (LAS int*)(F.lds + LDS_AUX + 8192); LAS int* tb = cntl + 64;
    const int c = (int)blockIdx.x;

    if (IN(0)) { phase_p0(F, fresh_args()); } SEAM(0);
    if (IN(1)) { phase_p1(F, fresh_args()); } SEAM(1);
    if (IN(2)) {
        ArgsP a = fresh_args(); unsigned char* ws = a->ws;
        DenseSched S; S.init(T, 4096, F.G, c);
        EpiGemm1 E{(bf16_t*)(ws + WS_SCR + 64 * MiB), (bf16_t*)(ws + WS_SCR + 128 * MiB), (float*)(ws + WS_VPART), a->in[7]};
        GEMM_RUN(2, false, (const bf16_t*)(ws + WS_SCR), (const bf16_t*)(ws + WS_WIN_T), 1024, S, E);
    } SEAM(2);
    if (IN(3)) { phase_p3(F, fresh_args()); } SEAM(3);
    if (IN(4)) {
        ArgsP a = fresh_args(); unsigned char* ws = a->ws;
        DenseSched S; S.init(T, 1024, F.G, c);
        EpiResid E{a->in[0], a->out, (const float*)(ws + WS_MOD) + 2048, 6144};
        GEMM_RUN(4, false, (const bf16_t*)(ws + WS_SCR + 64 * MiB), (const bf16_t*)(ws + WS_WOUT_T), 2048, S, E);
    } SEAM(4);
#define MOE_PHASES(layer, pb) \
    if (IN(pb)) { phase_router(F, fresh_args(), layer); } SEAM(pb); \
    if (IN(pb + 1)) { ArgsP a = fresh_args(); unsigned char* ws = a->ws; \
        moe_tables(F, a, layer, cntl, tb); \
        MoeSched<true> S; S.init(tb, cntl, (const int*)(ws + WS_TOKLIST), F.G, F.vcu); \
        EpiGateUp E{(bf16_t*)(ws + WS_H)}; \
        GEMM_RUN(6, true, (const bf16_t*)(ws + WS_SCR), (const bf16_t*)(ws + WS_GU), 1024, S, E); \
    } SEAM(pb + 1); \
    if (IN(pb + 2)) { ArgsP a = fresh_args(); unsigned char* ws = a->ws; \
        moe_tables(F, a, layer, cntl, tb); \
        MoeSched<false> S; S.init(tb, cntl, (const int*)(ws + WS_TOKLIST), F.G, F.vcu); \
        EpiDown E{(bf16_t*)(ws + WS_SCR), a->out, (const int*)(ws + WS_TOKLIST), (const float*)(ws + WS_WLIST), (const float*)(ws + WS_MOD) + (size_t)layer * MOD_L + 5120, 6144, tb}; \
        GEMM_RUN(7, false, (const bf16_t*)(ws + WS_H), (const bf16_t*)(ws + WS_DN), 256, S, E); \
    } SEAM(pb + 2);
    MOE_PHASES(0, 5)
    if (IN(8)) { phase_p8(F, fresh_args()); } SEAM(8);
    if (IN(9)) {
        ArgsP a = fresh_args(); unsigned char* ws = a->ws;
        DenseSched S; S.init(T, 3072, F.G, c, 4, T);
        EpiQKV E{(bf16_t*)(ws + WS_SCR + 64 * MiB), (float*)(ws + WS_CTL + CTL_KMEAN)};
        GEMM_RUN(9, false, (const bf16_t*)(ws + WS_H), (const bf16_t*)(ws + WS_WQKV_T), 1024, S, E);
    } SEAM(9);
    if (IN(10)) {
        ArgsP a = fresh_args(); unsigned char* ws = a->ws;
        const attn_body::AttnTensors AT{(const attn_body::bf16*)(ws + WS_SCR + 64 * MiB), (const attn_body::bf16*)(ws + WS_SCR + 96 * MiB), (const attn_body::bf16*)(ws + WS_SCR + 128 * MiB),
                                        (attn_body::bf16*)(ws + WS_SCR + 64 * MiB), (const float*)(ws + WS_CTL + CTL_KMEAN)};
        const attn_body::StaticOrder S((int)F.G, (int)blockIdx.x);
        attn_body::attn_phase<attn_body::StaticOrder>((char*)lds, AT, S);
    } SEAM(10);
    if (IN(11)) {
        ArgsP a = fresh_args(); unsigned char* ws = a->ws;
        DenseSched S; S.init(T, 1024, F.G, c);
        EpiResid E{a->out, a->out, (const float*)(ws + WS_MOD) + MOD_L + 2048, 6144};
        GEMM_RUN(11, false, (const bf16_t*)(ws + WS_SCR + 64 * MiB), (const bf16_t*)(ws + WS_WO_T), 1024, S, E);
    } SEAM(11);
    MOE_PHASES(1, 12)
    if (IN(15)) { phase_final(F, fresh_args()); }
#undef IN
#undef SEAM
#undef GRID_BAR
}

extern "C" void kernel_launch(void* const* d_in, const int* in_sizes, int n_in, void* d_out, int out_size, void* d_ws, size_t ws_size, hipStream_t stream) {
    static int grid = 0;
    if (grid == 0) {
        if (n_in != 29 || in_sizes[0] != T * D || out_size != T * D || ws_size < WS_END) {
            fprintf(stderr, "kernel_launch: shape/workspace mismatch: n_in %d in0 %d out %d ws %zu (need %zu); nothing launched\n", n_in, n_in > 0 ? in_sizes[0] : -1, out_size, ws_size, (size_t)WS_END); grid = -1; return; }
        int dev = 0, cus = 0, per_cu = 0;
        if (hipGetDevice(&dev) != hipSuccess || hipDeviceGetAttribute(&cus, hipDeviceAttributeMultiprocessorCount, dev) != hipSuccess) { grid = -1; return; }
        if (hipFuncSetAttribute((const void*)yoco_fwd, hipFuncAttributeMaxDynamicSharedMemorySize, LDS_BYTES) != hipSuccess) { fprintf(stderr, "kernel_launch: hipFuncSetAttribute failed\n"); grid = -1; return; }
        if (hipOccupancyMaxActiveBlocksPerMultiprocessor(&per_cu, (const void*)yoco_fwd, NTHREADS, LDS_BYTES) != hipSuccess || per_cu < 1)
            fprintf(stderr, "kernel_launch: note: occupancy query reports %d workgroups per CU\n", per_cu);
        (void)hipGetLastError();
        grid = cus;
    }
    if (grid < 0) return;
    if (hipMemsetAsync((char*)d_ws + WS_CTL, 0, CTL_ZERO_BYTES, stream) != hipSuccess) return;
    Args a{};
    for (int i = 0; i < 29; ++i) a.in[i] = (const float*)d_in[i];
    a.out = (float*)d_out; a.ws = (unsigned char*)d_ws;
    for (int li = 0; li < N_LAUNCHES; ++li) {
        a.ph_lo = (N_LAUNCHES == 1) ? 0 : li; a.ph_hi = (N_LAUNCHES == 1) ? N_PHASES : li + 1; a.li = li;
        hipLaunchKernelGGL(yoco_fwd, dim3(grid), dim3(NTHREADS), LDS_BYTES, stream, a);
    }
}
```

```cpp
#include <hip/hip_runtime.h>
#include <hip/hip_bf16.h>
#include <cstdio>
#include <cstdint>
#include <cmath>

#define GAS __attribute__((address_space(1)))
#define LAS __attribute__((address_space(3)))
typedef unsigned short bf16_t;
typedef short bf16x8 __attribute__((ext_vector_type(8)));
typedef float f32x4 __attribute__((ext_vector_type(4)));
typedef float f32x2 __attribute__((ext_vector_type(2)));
typedef unsigned u32x4 __attribute__((ext_vector_type(4)));
typedef unsigned u32x2 __attribute__((ext_vector_type(2)));
typedef __bf16 bf16x2_t __attribute__((ext_vector_type(2)));
typedef GAS unsigned gu32;

constexpr int T = 16384, D = 1024, NBATCH = 8, SEQ = 2048, NH = 16, HD = 64;
constexpr int AW = 2048;
constexpr int NE = 64, TOPK = 8, ED = 256, CAP = 16384;
constexpr float RMS_EPS = 1e-6f, LN_EPS = 1e-5f, ROUTED_SCALE = 2.5f;
constexpr float ATT_C2 = 0.125f * 1.4426950408889634f;
constexpr int NWAVES = 8, NTHREADS = 512;

constexpr size_t MiB = 1u << 20;
constexpr size_t WS_CTL = 0, CTL_ZERO_BYTES = 1 * MiB;
constexpr size_t WS_MOD = 1 * MiB;
constexpr size_t WS_VPART = 2 * MiB;
constexpr size_t WS_TOKLIST = 6 * MiB, WS_WLIST = 10 * MiB;
constexpr size_t WS_WIN_T = 14 * MiB;
constexpr size_t WS_WOUT_T = 22 * MiB;
constexpr size_t WS_WSP = 26 * MiB;
constexpr size_t WS_WQKV_T = 27 * MiB;
constexpr size_t WS_WO_T = 33 * MiB;
constexpr size_t WS_WR = 35 * MiB;
constexpr size_t WS_GU = 36 * MiB;
constexpr size_t WS_DN = 101 * MiB;
constexpr size_t WS_H = 134 * MiB;
constexpr size_t WS_SCR = 214 * MiB;
constexpr size_t WS_END = 470 * MiB;
constexpr int CW_TMO = 0, CW_CODE = 1, CW_BAR = 4096, CW_CNT = 8192;
constexpr size_t CTL_KMEAN = 65536;
constexpr int MOD_L = 8 * 6144;

constexpr int RING_BYTES = 131072;
constexpr int LDSCTL_OFF = RING_BYTES, MISC_OFF = LDSCTL_OFF + 320;
constexpr int LDS_AUX = RING_BYTES + 1024;
constexpr int LDS_BYTES = 147456;

#define RLX_AGENT __ATOMIC_RELAXED, __HIP_MEMORY_SCOPE_AGENT
#define LDS_WAIT() asm volatile("s_waitcnt lgkmcnt(0)" ::: "memory")
#define VM_WAIT() asm volatile("s_waitcnt vmcnt(0)" ::: "memory")

__device__ __forceinline__ unsigned f2bf(float f) { unsigned u = __builtin_bit_cast(unsigned, f); return (u + 0x7fffu + ((u >> 16) & 1u)) >> 16; }
__device__ __forceinline__ unsigned pk2(float lo, float hi) { f32x2 v = {lo, hi}; bf16x2_t b = __builtin_convertvector(v, bf16x2_t); return __builtin_bit_cast(unsigned, b); }
__device__ __forceinline__ float bf_lo(unsigned w) { return __uint_as_float(w << 16); }
__device__ __forceinline__ float bf_hi(unsigned w) { return __uint_as_float(w & 0xffff0000u); }
__device__ __forceinline__ float wave_sum(float v) {
#pragma unroll
    for (int o = 1; o < 64; o <<= 1) v += __shfl_xor(v, o);
    return v;
}
__device__ __forceinline__ float gelu_tanh(float x) {
    const float t = x * x, inner = x * (0.7978845608f + 0.0356774081f * t);
    const float e = __builtin_amdgcn_exp2f(-2.885390082f * inner);
    return x * __builtin_amdgcn_rcpf(1.0f + e);
}
__device__ __forceinline__ float silu_f(float x) { return x / (1.0f + __expf(-x)); }
#define XB_TMO      128
#define XB_XCNT(j)  (256  + 64 * (j))
#define XB_XSUB(j)  (1280 + 64 * (j))
#define XB_XGEN(j)  (2304 + 64 * (j))
#define XB_TOP      3328
#define XB_TOPGEN   3392
#define XCD_BAR_WORDS 3456
#define XB_SPIN_CAP (1u << 20)
__device__ __forceinline__ unsigned xb_ld(unsigned* p)              { return __hip_atomic_load(p, __ATOMIC_RELAXED, __HIP_MEMORY_SCOPE_AGENT); }
__device__ __forceinline__ unsigned xb_add(unsigned* p, unsigned v) { return __hip_atomic_fetch_add(p, v, __ATOMIC_RELAXED, __HIP_MEMORY_SCOPE_AGENT); }
__device__ __forceinline__ unsigned xb_xcc_id() { return (unsigned)__builtin_amdgcn_s_getreg((3 << 11) | 20) & 0xFu; }
#define XB_SPIN(cond, bar) do { unsigned _sp = 0; while (cond) { __builtin_amdgcn_s_sleep(1); \
    if ((++_sp & 255u) == 0u) { if (xb_ld(&(bar)[XB_TMO])) break; if (_sp > XB_SPIN_CAP) { atomicAdd(&(bar)[XB_TMO], 1u); break; } } } } while (0)

struct XcdBarrier {
    unsigned* bar; unsigned x;
    volatile LAS unsigned* st;
};

__device__ __forceinline__ XcdBarrier xcd_barrier_post(unsigned* bar, volatile LAS unsigned* st) {
    XcdBarrier b; b.bar = bar; b.x = xb_xcc_id(); b.st = st;
    if (threadIdx.x == 0) (void)xb_add(&bar[XB_XCNT(b.x)], 1u);
    return b;
}
__device__ __forceinline__ void xcd_barrier_complete(unsigned* bar, unsigned x, unsigned& nloc, unsigned& nx) {
    const unsigned G = gridDim.x * gridDim.y * gridDim.z;
    unsigned sum, cnt, mine, sp = 0u;
    for (;;) {
        sum = 0u; cnt = 0u; mine = 0u;
#pragma unroll
        for (unsigned j = 0; j < 16; ++j) { const unsigned c = xb_ld(&bar[XB_XCNT(j)]); sum += c; cnt += (c > 0u) ? 1u : 0u; mine = (j == x) ? c : mine; }
        if (sum == G) break;
        __builtin_amdgcn_s_sleep(1);
        if ((++sp & 255u) == 0u) { if (xb_ld(&bar[XB_TMO])) break; if (sp > XB_SPIN_CAP) { atomicAdd(&bar[XB_TMO], 1u); break; } }
    }
    nloc = mine > 0u ? mine : 1u; nx = cnt > 0u ? cnt : 1u;
}

__device__ __forceinline__ void xcd_barrier(const XcdBarrier& b) {
    asm volatile("s_waitcnt vmcnt(0)" ::: "memory");
    __syncthreads();
    if (threadIdx.x == 0) {
        unsigned* bar = b.bar;
        __builtin_amdgcn_s_waitcnt(0);
        unsigned nloc = b.st[0], nx = b.st[1];
        if (nloc == 0u) { xcd_barrier_complete(bar, b.x, nloc, nx); b.st[0] = nloc; b.st[1] = nx; }
        const unsigned old = xb_add(&bar[XB_XSUB(b.x)], 1u);
        const unsigned gen = old / nloc;
        if (old + 1u == (gen + 1u) * nloc) {
            __builtin_amdgcn_fence(__ATOMIC_RELEASE, "agent");
            asm volatile("s_waitcnt vmcnt(0)" ::: "memory");
            const unsigned og = xb_add(&bar[XB_TOP], 1u);
            const unsigned tg = og / nx;
            if (og + 1u == (tg + 1u) * nx) xb_add(&bar[XB_TOPGEN], 1u);
            else XB_SPIN(xb_ld(&bar[XB_TOPGEN]) == tg, bar);
            __builtin_amdgcn_fence(__ATOMIC_ACQUIRE, "agent");
            xb_add(&bar[XB_XGEN(b.x)], 1u);
            asm volatile("s_waitcnt vmcnt(0)" ::: "memory");
        } else {
            XB_SPIN(xb_ld(&bar[XB_XGEN(b.x)]) == gen, bar);
            __builtin_amdgcn_fence(__ATOMIC_ACQUIRE, "agent");
            asm volatile("s_waitcnt vmcnt(0)" ::: "memory");
        }
    }
    __syncthreads();
}

__host__ __device__ __forceinline__ int perm32(int rho) { const int n = rho >> 4, i = rho & 15; return 8 * (i >> 2) + 4 * n + (i & 3); }

struct Unit { int pm, pn, arow, brow, e, nvalid, lbase; };

constexpr int NXCD = 8, WGM = 8;
struct DenseSched {
    int nM, nN, nwg, G, c, a_split_pn, a_split_rows;
    __device__ __forceinline__ void init(int M, int N, int G_, int c_, int spn = 1 << 30, int srows = 0) { nM = M / 256; nN = N / 256; nwg = nM * nN; G = G_; c = c_; a_split_pn = spn; a_split_rows = srows; }
    __device__ __forceinline__ bool next(int i, Unit& u) const {
        const long L = (long)i * G + c; if (L >= nwg) return false;
        int wgid = (int)L; { const int q = nwg / NXCD, r = nwg % NXCD, xcd = wgid % NXCD, off = wgid / NXCD; wgid = (xcd < r ? xcd * (q + 1) : r * (q + 1) + (xcd - r) * q) + off; }
        const int nig = WGM * nN, gid = wgid / nig, fm = gid * WGM, gsz = (nM - fm) < WGM ? (nM - fm) : WGM;
        u.pm = fm + ((wgid % nig) % gsz); u.pn = (wgid % nig) / gsz;
        u.arow = u.pm * 256 + (u.pn >= a_split_pn ? a_split_rows : 0); u.brow = u.pn * 256; u.e = -1; u.nvalid = 256; u.lbase = 0; return true;
    }
    __device__ __forceinline__ int a_row(const Unit& u, int r) const { return u.arow + r; }
};
template <bool GATE_UP> struct MoeSched {
    const LAS int* tb; const LAS int* cnt; const int* toklist; int G, c, ncol, nunits;
    __device__ __forceinline__ void init(const LAS int* tb_, const LAS int* cnt_, const int* tl, int G_, int c_) { tb = tb_; cnt = cnt_; toklist = tl; G = G_; c = c_; ncol = GATE_UP ? 2 : 4; nunits = tb_[65] * ncol; }
    __device__ __forceinline__ bool next(int i, Unit& u) const {
        const int L = i * G + c; if (L >= nunits) return false;
        const int rt = L / ncol; u.pn = L % ncol; u.pm = rt;
        int e = 0;
#pragma unroll 1
        for (int j = 64; j > 0; j >>= 1) if (e + j <= 64 && tb[e + j] <= rt) e += j;
        while (e < 64 && tb[e + 1] <= rt) ++e;
        u.e = e;
        const int ti = rt - tb[e];
        if (e < 64) { const int left = cnt[e] - ti * 256; u.nvalid = left < 256 ? left : 256; u.lbase = e * CAP + ti * 256; u.arow = GATE_UP ? 0 : rt * 256; }
        else { u.nvalid = 256; u.lbase = 0; u.arow = GATE_UP ? ti * 256 : rt * 256; }
        u.brow = GATE_UP ? (e * 512 + u.pn * 256) : (e * 1024 + u.pn * 256);
        return true;
    }
    __device__ __forceinline__ int a_row(const Unit& u, int r) const {
        if (!GATE_UP) return u.arow + r;
        if (u.e == 64) return u.arow + r;
        return (r < u.nvalid) ? (toklist[u.lbase + r] >> 3) : 0;
    }
};

template <class Epi, class Sched>
__device__ __forceinline__ void gemm_ref(const bf16_t* A, const bf16_t* Bt, int K, const Sched& S, const Epi& E) {
    const int tid = threadIdx.x, wid = __builtin_amdgcn_readfirstlane(tid >> 6), lane = tid & 63, wr = wid >> 2, wc = wid & 3, fr = lane & 15, fq = lane >> 4;
    Unit u;
    for (int i = 0; S.next(i, u); ++i) {
        f32x4 acc[2][2][4][2];
#pragma unroll
        for (int a = 0; a < 2; ++a)
#pragma unroll
            for (int b = 0; b < 2; ++b)
#pragma unroll
                for (int m = 0; m < 4; ++m)
#pragma unroll
                    for (int n = 0; n < 2; ++n) acc[a][b][m][n] = (f32x4){0.f, 0.f, 0.f, 0.f};
        unsigned aoff[2][4], boff[2][2];
#pragma unroll
        for (int ai = 0; ai < 2; ++ai)
#pragma unroll
            for (int m = 0; m < 4; ++m) aoff[ai][m] = (unsigned)S.a_row(u, 128 * ai + 64 * wr + 16 * m + fr) * (unsigned)K + 8u * fq;
#pragma unroll
        for (int bj = 0; bj < 2; ++bj)
#pragma unroll
            for (int n = 0; n < 2; ++n) boff[bj][n] = (unsigned)(u.brow + 128 * bj + 32 * wc + (Epi::PERM ? perm32(16 * n + fr) : 16 * n + fr)) * (unsigned)K + 8u * fq;
#pragma unroll 1
        for (int kk = 0; kk < K; kk += 32) {
            bf16x8 af[2][4], bfr[2][2];
#pragma unroll
            for (int ai = 0; ai < 2; ++ai)
#pragma unroll
                for (int m = 0; m < 4; ++m) af[ai][m] = *(const bf16x8*)(A + (size_t)aoff[ai][m] + kk);
#pragma unroll
            for (int bj = 0; bj < 2; ++bj)
#pragma unroll
                for (int n = 0; n < 2; ++n) bfr[bj][n] = *(const bf16x8*)(Bt + (size_t)boff[bj][n] + kk);
#pragma unroll
            for (int ai = 0; ai < 2; ++ai)
#pragma unroll
                for (int bj = 0; bj < 2; ++bj)
#pragma unroll
                    for (int m = 0; m < 4; ++m)
#pragma unroll
                        for (int n = 0; n < 2; ++n) acc[ai][bj][m][n] = __builtin_amdgcn_mfma_f32_16x16x32_bf16(bfr[bj][n], af[ai][m], acc[ai][bj][m][n], 0, 0, 0);
        }
        E(acc, u, wr, wc, fr, fq);
    }
}

struct EpiGemm1 {
    static constexpr bool PERM = true;
    bf16_t* U; bf16_t* VT; float* vpart; const float* bias;
    __device__ __forceinline__ void operator()(const f32x4 (&acc)[2][2][4][2], const Unit& u, int wr, int wc, int fr, int fq) const {
        const int colt = u.pn * 256; const bool isv = colt >= AW;
        f32x4 bv[2][2];
#pragma unroll
        for (int bj = 0; bj < 2; ++bj)
#pragma unroll
            for (int n = 0; n < 2; ++n) bv[bj][n] = *(const f32x4*)(bias + colt + 128 * bj + 32 * wc + 8 * fq + 4 * n);
#pragma unroll
        for (int ai = 0; ai < 2; ++ai)
#pragma unroll
            for (int m = 0; m < 4; ++m) {
                const int row = u.pm * 256 + 128 * ai + 64 * wr + 16 * m + fr;
                float s1 = 0.f, s2 = 0.f;
#pragma unroll
                for (int bj = 0; bj < 2; ++bj) {
                    float v[8];
#pragma unroll
                    for (int n = 0; n < 2; ++n)
#pragma unroll
                        for (int j = 0; j < 4; ++j) v[4 * n + j] = gelu_tanh(acc[ai][bj][m][n][j] + bv[bj][n][j]);
                    const int col = colt + 128 * bj + 32 * wc + 8 * fq;
                    if (!isv) {
                        u32x4 w; w.x = pk2(v[0], v[1]); w.y = pk2(v[2], v[3]); w.z = pk2(v[4], v[5]); w.w = pk2(v[6], v[7]);
                        *(u32x4*)(U + (size_t)row * AW + col) = w;
                    } else {
                        bf16_t* vt = VT + ((size_t)(row >> 7) * AW + (col - AW)) * 128 + (row & 127);
#pragma unroll
                        for (int j = 0; j < 8; ++j) { vt[(size_t)j * 128] = (bf16_t)f2bf(v[j]); s1 += v[j]; s2 += v[j] * v[j]; }
                    }
                }
                if (isv) {
                    s1 += __shfl_xor(s1, 16); s1 += __shfl_xor(s1, 32); s2 += __shfl_xor(s2, 16); s2 += __shfl_xor(s2, 32);
                    if (fq == 0) { float* p = vpart + ((size_t)row * 32 + (u.pn - 8) * 4 + wc) * 2; *(f32x2*)p = (f32x2){s1, s2}; }
                }
            }
    }
};
struct EpiResid {
    static constexpr bool PERM = false;
    const float* base; float* out; const float* gate;
    int gstride;
    __device__ __forceinline__ void operator()(const f32x4 (&acc)[2][2][4][2], const Unit& u, int wr, int wc, int fr, int fq) const {
        const int b = (u.pm * 256) / SEQ;
        f32x4 gv[2][2];
#pragma unroll
        for (int bj = 0; bj < 2; ++bj)
#pragma unroll
            for (int n = 0; n < 2; ++n) gv[bj][n] = *(const f32x4*)(gate + (size_t)b * gstride + u.pn * 256 + 128 * bj + 32 * wc + 16 * n + 4 * fq);
#pragma unroll
        for (int ai = 0; ai < 2; ++ai)
#pragma unroll
            for (int m = 0; m < 4; ++m) {
                const size_t off = (size_t)(u.pm * 256 + 128 * ai + 64 * wr + 16 * m + fr) * D + u.pn * 256 + 32 * wc + 4 * fq;
#pragma unroll
                for (int bj = 0; bj < 2; ++bj)
#pragma unroll
                    for (int n = 0; n < 2; ++n) { const f32x4 bs = *(const f32x4*)(base + off + 128 * bj + 16 * n); *(f32x4*)(out + off + 128 * bj + 16 * n) = bs + gv[bj][n] * acc[ai][bj][m][n]; }
                if (m & 1) asm volatile("" ::: "memory");
            }
    }
};
struct EpiGateUp {
    static constexpr bool PERM = true;
    bf16_t* Hb;
    __device__ __forceinline__ void operator()(const f32x4 (&acc)[2][2][4][2], const Unit& u, int wr, int wc, int fr, int fq) const {
#pragma unroll
        for (int ai = 0; ai < 2; ++ai)
#pragma unroll
            for (int m = 0; m < 4; ++m) {
                const int r = 128 * ai + 64 * wr + 16 * m + fr;
                float v[8];
#pragma unroll
                for (int n = 0; n < 2; ++n)
#pragma unroll
                    for (int j = 0; j < 4; ++j) { const float g = acc[ai][0][m][n][j], up = acc[ai][1][m][n][j]; v[4 * n + j] = silu_f(g) * up; }
                u32x4 w; w.x = pk2(v[0], v[1]); w.y = pk2(v[2], v[3]); w.z = pk2(v[4], v[5]); w.w = pk2(v[6], v[7]);
                *(u32x4*)(Hb + (size_t)(u.pm * 256 + r) * ED + u.pn * 128 + 32 * wc + 8 * fq) = w;
            }
    }
};
struct EpiDown {
    static constexpr bool PERM = true;
    bf16_t* Y; float* X; const int* toklist; const float* wlist; const float* gate; int gstride; const LAS int* tb;
    __device__ __forceinline__ void operator()(const f32x4 (&acc)[2][2][4][2], const Unit& u, int wr, int wc, int fr, int fq) const {
        const int colb = u.pn * 256 + 32 * wc + 8 * fq;
        if (u.e < 64) {
#pragma unroll
            for (int ai = 0; ai < 2; ++ai)
#pragma unroll
                for (int m = 0; m < 4; ++m) {
                    const int r = 128 * ai + 64 * wr + 16 * m + fr;
                    if (r < u.nvalid) {
                        const int ent = toklist[u.lbase + r]; const float w = wlist[u.lbase + r];
#pragma unroll
                        for (int bj = 0; bj < 2; ++bj) { const f32x4 a0 = acc[ai][bj][m][0] * w, a1 = acc[ai][bj][m][1] * w;
                            u32x4 o; o.x = pk2(a0[0], a0[1]); o.y = pk2(a0[2], a0[3]); o.z = pk2(a1[0], a1[1]); o.w = pk2(a1[2], a1[3]);
                            *(u32x4*)(Y + (size_t)ent * D + colb + 128 * bj) = o; }
                    }
                    if (m & 1) asm volatile("" ::: "memory");
                }
        } else {
            const int t0 = (u.pm - tb[64]) * 256; const int b = t0 / SEQ;
#pragma unroll
            for (int ai = 0; ai < 2; ++ai)
#pragma unroll
                for (int m = 0; m < 4; ++m) {
                    const int r = 128 * ai + 64 * wr + 16 * m + fr;
                    float* xr = X + (size_t)(t0 + r) * D + colb;
#pragma unroll
                    for (int bj = 0; bj < 2; ++bj)
#pragma unroll
                        for (int n = 0; n < 2; ++n) { const f32x4 g = *(const f32x4*)(gate + (size_t)b * gstride + colb + 128 * bj + 4 * n); f32x4* p = (f32x4*)(xr + 128 * bj + 4 * n); *p = *p + g * acc[ai][bj][m][n]; }
                    asm volatile("" ::: "memory");
                }
        }
    }
};
struct EpiQKV {
    static constexpr bool PERM = true;
    bf16_t* Q; float* kmean;
    __device__ __forceinline__ void operator()(const f32x4 (&acc)[2][2][4][2], const Unit& u, int wr, int wc, int fr, int fq) const {
        const int which = u.pn >> 2, colt = (u.pn & 3) * 256;
        bf16_t* base = Q + (size_t)which * ((size_t)T * D);
        const float sc = which == 0 ? ATT_C2 : 1.0f;
        const int col0 = colt + 32 * wc + 8 * fq;
        float cs[2][8];
#pragma unroll
        for (int bj = 0; bj < 2; ++bj)
#pragma unroll
            for (int j = 0; j < 8; ++j) cs[bj][j] = 0.f;
#pragma unroll
        for (int ai = 0; ai < 2; ++ai)
#pragma unroll
            for (int m = 0; m < 4; ++m) {
                bf16_t* rowp = base + (size_t)(u.pm * 256 + 128 * ai + 64 * wr + 16 * m + fr) * D + col0;
#pragma unroll
                for (int bj = 0; bj < 2; ++bj) { const f32x4 v0 = acc[ai][bj][m][0] * sc, v1 = acc[ai][bj][m][1] * sc;
                    u32x4 w; w.x = pk2(v0[0], v0[1]); w.y = pk2(v0[2], v0[3]); w.z = pk2(v1[0], v1[1]); w.w = pk2(v1[2], v1[3]);
                    *(u32x4*)(rowp + 128 * bj) = w;
#pragma unroll
                    for (int j = 0; j < 4; ++j) { cs[bj][j] += v0[j]; cs[bj][4 + j] += v1[j]; } }
            }
        if (which == 1) {
#pragma unroll
            for (int bj = 0; bj < 2; ++bj)
#pragma unroll
                for (int j = 0; j < 8; ++j) { float s = cs[bj][j]; s += __shfl_xor(s, 1); s += __shfl_xor(s, 2); s += __shfl_xor(s, 4); s += __shfl_xor(s, 8); cs[bj][j] = s; }
            if (fr == 0) {
                const int b = u.pm >> 3, blk = u.pm & 7;
#pragma unroll
                for (int bj = 0; bj < 2; ++bj)
#pragma unroll
                    for (int j = 0; j < 8; ++j) { const int c = col0 + 128 * bj + j, h = c >> 6, d = c & 63;
                        atomicAdd(kmean + (((size_t)b * NH + h) * 8 + blk) * 64 + d, cs[bj][j] * (1.0f / 256.0f)); }
            }
        }
    }
};
namespace pg8 {
constexpr int BM = 256, BK = 64, HALF = 128, HTB = HALF * BK * 2, STAGE_BYTES = 8 * HTB;
__host__ __device__ __forceinline__ int lds_byte(int r, int c) { const int st = (r >> 4) * 2 + (c >> 5), rr = r & 15, cc = c & 31, ob = rr * 64 + cc * 2; return st * 1024 + (ob ^ (((ob >> 9) & 1) << 5)); }
__host__ __device__ __forceinline__ void stage_rc(int b, int& R, int& C) { const int st = b / 1024, sb = b % 1024, swz = sb ^ (((sb >> 9) & 1) << 5); R = (st >> 1) * 16 + swz / 64; C = (st & 1) * 32 + (swz % 64) / 2; }

template <bool GATHER, class Epi, class Sched>
__device__ __forceinline__ void gemm_phase(LAS unsigned char* lds, const bf16_t* Ab, const bf16_t* Btb, const int K, const Sched& S, const Epi& E) {
    const int tid = threadIdx.x, wid = __builtin_amdgcn_readfirstlane(tid >> 6), lane = tid & 63, wr = wid >> 2, wc = wid & 3, fr = lane & 15, fq = lane >> 4;
    const int nt = K / BK;
    unsigned voffA[2][2], nvoffA[2][2], voffB[2]; int RA[2], CA[2];
#pragma unroll
    for (int i = 0; i < 2; ++i) { int R, C; stage_rc(tid * 16 + i * 8192, R, C); const int Rb = Epi::PERM ? ((R & ~31) + perm32(R & 31)) : R;
        RA[i] = R; CA[i] = C; voffA[0][i] = (unsigned)(R * K + C) * 2u; voffA[1][i] = voffA[0][i]; nvoffA[0][i] = voffA[0][i]; nvoffA[1][i] = voffA[0][i]; voffB[i] = (unsigned)(Rb * K + C) * 2u; }
    const size_t kstep = (size_t)(BK * 2);
    const size_t hstep = (size_t)HALF * K * 2;
    const unsigned ldsw = (unsigned)wid * 1024u;
    const int aoff = lds_byte(wr * 64 + fr, fq * 8), boff = lds_byte(wc * 32 + fr, fq * 8);
#define PG8_SA(b, h) (((b) * 2 + (h)) * HTB)
#define PG8_SB(b, h) ((4 + (b) * 2 + (h)) * HTB)
#define PG8_STAGE(bufoff, gbase, voff) do { _Pragma("unroll") for (int _i = 0; _i < 2; ++_i) \
        __builtin_amdgcn_global_load_lds((const unsigned*)((const char*)(gbase) + (voff)[_i]), (LAS unsigned*)(lds + (bufoff) + ldsw + _i * 8192), 16, 0, 0); } while (0)
#define PG8_LDA(dst, b, h) do { _Pragma("unroll") for (int m = 0; m < 4; ++m) _Pragma("unroll") for (int k = 0; k < 2; ++k) dst[m][k] = *(const LAS bf16x8*)(lds + PG8_SA(b, h) + aoff + m * 2048 + k * 1024); } while (0)
#define PG8_LDB(dst, b, h) do { _Pragma("unroll") for (int n = 0; n < 2; ++n) _Pragma("unroll") for (int k = 0; k < 2; ++k) dst[n][k] = *(const LAS bf16x8*)(lds + PG8_SB(b, h) + boff + n * 2048 + k * 1024); } while (0)
#define PG8_MMA(ai, bj, At, Bt) do { __builtin_amdgcn_s_setprio(1); _Pragma("unroll") for (int m = 0; m < 4; ++m) _Pragma("unroll") for (int n = 0; n < 2; ++n) _Pragma("unroll") for (int k = 0; k < 2; ++k) \
        acc[ai][bj][m][n] = __builtin_amdgcn_mfma_f32_16x16x32_bf16(Bt[n][k], At[m][k], acc[ai][bj][m][n], 0, 0, 0); __builtin_amdgcn_s_setprio(0); } while (0)
#define PG8_WAIT_V(n) asm volatile("s_waitcnt vmcnt(" #n ")" ::: "memory")
#define PG8_WAIT_L(n) asm volatile("s_waitcnt lgkmcnt(" #n ")" ::: "memory")
#define PG8_BAR __builtin_amdgcn_s_barrier()
#define PG8_SCHED __builtin_amdgcn_sched_barrier(0)
#define PG8_GATHER_OFFS(dst, u) do { if (GATHER) { _Pragma("unroll") for (int _h = 0; _h < 2; ++_h) _Pragma("unroll") for (int _i = 0; _i < 2; ++_i) \
        dst[_h][_i] = ((unsigned)S.a_row(u, 128 * _h + RA[_i]) * (unsigned)K + (unsigned)CA[_i]) * 2u; } } while (0)
    Unit cur, nxt; int ui = 0;
    if (!S.next(0, cur)) return;
    f32x4 acc[2][2][4][2];
#pragma unroll
    for (int a = 0; a < 2; ++a)
#pragma unroll
        for (int b = 0; b < 2; ++b)
#pragma unroll
            for (int m = 0; m < 4; ++m)
#pragma unroll
                for (int n = 0; n < 2; ++n) acc[a][b][m][n] = (f32x4){0.f, 0.f, 0.f, 0.f};
    bf16x8 At[4][2], B0[2][2], B1[2][2];
    PG8_GATHER_OFFS(voffA, cur);
    const char* cA0 = GATHER ? (const char*)Ab : (const char*)Ab + (size_t)cur.arow * K * 2; const char* cA1 = GATHER ? cA0 : cA0 + hstep;
    const char* cB = (const char*)Btb + (size_t)cur.brow * K * 2;
    PG8_STAGE(PG8_SB(0, 0), cB, voffB); PG8_STAGE(PG8_SB(0, 1), cB + hstep, voffB); PG8_STAGE(PG8_SA(0, 0), cA0, voffA[0]); PG8_STAGE(PG8_SA(0, 1), cA1, voffA[1]);
    if (wr == 1) PG8_BAR;
    PG8_WAIT_V(2); PG8_BAR;
    PG8_STAGE(PG8_SB(1, 0), cB + kstep, voffB); PG8_STAGE(PG8_SA(1, 0), cA0 + kstep, voffA[0]); PG8_STAGE(PG8_SB(1, 1), cB + hstep + kstep, voffB);
    PG8_WAIT_V(6); PG8_BAR;
    for (;;) {
        const bool has_next = S.next(ui + 1, nxt);
        if (has_next) PG8_GATHER_OFFS(nvoffA, nxt);
        else if (GATHER) { _Pragma("unroll") for (int _h = 0; _h < 2; ++_h) _Pragma("unroll") for (int _i = 0; _i < 2; ++_i) nvoffA[_h][_i] = voffA[_h][_i]; }
        const char* nA0 = GATHER ? cA0 : (has_next ? (const char*)Ab + (size_t)nxt.arow * K * 2 : cA0); const char* nA1 = GATHER ? nA0 : nA0 + hstep;
        const char* nB = has_next ? (const char*)Btb + (size_t)nxt.brow * K * 2 : cB;
#pragma unroll 1
        for (int t = 0; t < nt; t += 2) {
            const bool last = (t == nt - 2);
            const char* a1h1 = cA1 + (size_t)(t + 1) * kstep;
            const char* a2h0 = last ? nA0 : cA0 + (size_t)(t + 2) * kstep; const char* a2h1 = last ? nA1 : cA1 + (size_t)(t + 2) * kstep;
            const char* b2 = last ? nB : cB + (size_t)(t + 2) * kstep;
            const char* a3h0 = a2h0 + kstep; const char* a3h1 = a2h1 + kstep; const char* b3 = b2 + kstep;
            unsigned v2h0[2], v2h1[2];
#pragma unroll
            for (int i = 0; i < 2; ++i) { v2h0[i] = (GATHER && last) ? nvoffA[0][i] : voffA[0][i]; v2h1[i] = (GATHER && last) ? nvoffA[1][i] : voffA[1][i]; }
            PG8_LDB(B0, 0, 0); PG8_LDB(B1, 0, 1); PG8_SCHED; PG8_LDA(At, 0, 0); PG8_STAGE(PG8_SA(1, 1), a1h1, voffA[1]);
            PG8_WAIT_V(8); PG8_WAIT_L(0); PG8_BAR; PG8_MMA(0, 0, At, B0); PG8_MMA(0, 1, At, B1); PG8_BAR; PG8_SCHED;
            PG8_LDA(At, 0, 1); PG8_STAGE(PG8_SB(0, 0), b2, voffB); PG8_STAGE(PG8_SB(0, 1), b2 + hstep, voffB); PG8_STAGE(PG8_SA(0, 0), a2h0, v2h0);
            PG8_WAIT_V(8); PG8_WAIT_L(0); PG8_BAR; PG8_MMA(1, 0, At, B0); PG8_MMA(1, 1, At, B1); PG8_BAR; PG8_SCHED;
            PG8_LDB(B0, 1, 0); PG8_LDB(B1, 1, 1); PG8_SCHED; PG8_LDA(At, 1, 0); PG8_STAGE(PG8_SA(0, 1), a2h1, v2h1);
            PG8_WAIT_V(8); PG8_WAIT_L(0); PG8_BAR; PG8_MMA(0, 0, At, B0); PG8_MMA(0, 1, At, B1); PG8_BAR; PG8_SCHED;
            PG8_LDA(At, 1, 1); PG8_STAGE(PG8_SB(1, 0), b3, voffB); PG8_STAGE(PG8_SB(1, 1), b3 + hstep, voffB); PG8_STAGE(PG8_SA(1, 0), a3h0, v2h0);
            PG8_WAIT_V(8); PG8_WAIT_L(0); PG8_BAR; PG8_MMA(1, 0, At, B0); PG8_MMA(1, 1, At, B1); PG8_BAR; PG8_SCHED;
        }
        if (wr == 0) PG8_BAR;
        E(acc, cur, wr, wc, fr, fq);
        if (!has_next) break;
#pragma unroll
        for (int a = 0; a < 2; ++a)
#pragma unroll
            for (int b = 0; b < 2; ++b)
#pragma unroll
                for (int m = 0; m < 4; ++m)
#pragma unroll
                    for (int n = 0; n < 2; ++n) acc[a][b][m][n] = (f32x4){0.f, 0.f, 0.f, 0.f};
        cur = nxt; cA0 = nA0; cA1 = nA1; cB = nB; ++ui;
        if (GATHER) { _Pragma("unroll") for (int _h = 0; _h < 2; ++_h) _Pragma("unroll") for (int _i = 0; _i < 2; ++_i) voffA[_h][_i] = nvoffA[_h][_i]; }
        if (wr == 1) PG8_BAR;
    }
    PG8_WAIT_V(0);
    PG8_BAR;
#undef PG8_SA
#undef PG8_SB
#undef PG8_STAGE
#undef PG8_LDA
#undef PG8_LDB
#undef PG8_MMA
#undef PG8_WAIT_V
#undef PG8_WAIT_L
#undef PG8_BAR
#undef PG8_SCHED
#undef PG8_GATHER_OFFS
}
}
#include <hip/hip_bf16.h>
#include <cmath>
namespace attn_body {
using bf16=__hip_bfloat16;
using bf16x8=__attribute__((ext_vector_type(8)))short;
using s16x4=__attribute__((ext_vector_type(4)))short;
using f32x16=__attribute__((ext_vector_type(16)))float;
using u32x4=__attribute__((ext_vector_type(4)))unsigned;
constexpr int BATCH=8,NHEAD=16,SEQ=2048,D=64,DM=NHEAD*D;
constexpr int NW=8,QBLK=32,QB=QBLK*NW,KVBLK=64,NQB=SEQ/QB;
constexpr int ATTN_PITCH=DM, ATTN_UNIT_ROWS=QB;
__device__ __forceinline__ int crow(int r,int hi){return (r&3)+8*(r>>2)+4*hi;}
#define SBAR() __builtin_amdgcn_sched_barrier(0)
__device__ __forceinline__ void cmask(f32x16&p0,f32x16&p1,int jb,int qrel,int hi){
  const float NEG=-INFINITY; int kb=64*jb+4*hi;
  #pragma unroll
  for(int r=0;r<16;++r){int kv=kb+(r&3)+8*(r>>2); if(kv>qrel)p0[r]=NEG; if(kv+32>qrel)p1[r]=NEG;}
}

constexpr int NSLOT=3, SLOTB=8192;
constexpr int LDS_K=0, LDS_V=NSLOT*SLOTB, LDS_WS=2*NSLOT*SLOTB, LDS_OST=LDS_WS+NW*64*4, LDS_BYTES=LDS_OST+NW*4096;
constexpr float C2=0.125f*1.4426950408889634f;
__device__ __forceinline__ void glds16(const void*gsrc,unsigned lds_dst){unsigned keep;
  asm volatile("s_mov_b32 %0, m0\n\ts_mov_b32 m0, %2\n\ts_nop 0\n\tglobal_load_lds_dwordx4 %1, off\n\ts_mov_b32 m0, %0":"=&s"(keep):"v"(gsrc),"s"(lds_dst):"memory");}
__device__ __forceinline__ float max3f(float a,float b,float c){float r;asm("v_max3_f32 %0, %1, %2, %3":"=v"(r):"v"(a),"v"(b),"v"(c));return r;}
__device__ __forceinline__ float max2f(float a,float b){float r;asm("v_max_f32_e32 %0, %1, %2":"=v"(r):"v"(a),"v"(b));return r;}
__device__ __forceinline__ float fadd_s(float a,float b){float r;asm("v_add_f32_e32 %0, %1, %2":"=v"(r):"v"(a),"v"(b));return r;}
__device__ __forceinline__ float fsub_s(float a,float b){float r;asm("v_sub_f32_e32 %0, %1, %2":"=v"(r):"v"(a),"v"(b));return r;}
typedef float f32x2_t __attribute__((ext_vector_type(2))); typedef float f32x4_t __attribute__((ext_vector_type(4)));
__device__ __forceinline__ float bf2f(short v){return __uint_as_float(((unsigned)(unsigned short)v)<<16);} typedef __bf16 bf16x2_t __attribute__((ext_vector_type(2)));
__device__ __forceinline__ unsigned cvtpk_s(float lo,float hi){f32x2_t v={lo,hi};bf16x2_t b=__builtin_convertvector(v,bf16x2_t);return __builtin_bit_cast(unsigned,b);}
#define WAIT_BAR(N) asm volatile("s_waitcnt vmcnt(" #N ") lgkmcnt(0)\n\ts_barrier":::"memory")

__device__ __forceinline__ void qkt(f32x16&p0,f32x16&p1,const char*Kslot,const bf16x8*qr,const f32x16&negm,int r32,int hi){
  const char*kb=Kslot+hi*1024+r32*16;
  #pragma unroll
  for(int d0=0;d0<4;++d0){
    const bf16x8 b0=*reinterpret_cast<const bf16x8*>(kb+d0*2048);
    const bf16x8 b1=*reinterpret_cast<const bf16x8*>(kb+d0*2048+512);
    if(d0==0){p0=__builtin_amdgcn_mfma_f32_32x32x16_bf16(b0,qr[0],negm,0,0,0);p1=__builtin_amdgcn_mfma_f32_32x32x16_bf16(b1,qr[0],negm,0,0,0);}
    else{p0=__builtin_amdgcn_mfma_f32_32x32x16_bf16(b0,qr[d0],p0,0,0,0);p1=__builtin_amdgcn_mfma_f32_32x32x16_bf16(b1,qr[d0],p1,0,0,0);}}
}
typedef __attribute__((address_space(3))) const char* lds_cptr;
typedef short v4i16_t __attribute__((ext_vector_type(4)));
__device__ __forceinline__ void kload8(bf16x8*kf,lds_cptr kp){
  kf[0]=*(const __attribute__((address_space(3))) bf16x8*)(kp);      kf[1]=*(const __attribute__((address_space(3))) bf16x8*)(kp+512);
  kf[2]=*(const __attribute__((address_space(3))) bf16x8*)(kp+2048); kf[3]=*(const __attribute__((address_space(3))) bf16x8*)(kp+2560);
  kf[4]=*(const __attribute__((address_space(3))) bf16x8*)(kp+4096); kf[5]=*(const __attribute__((address_space(3))) bf16x8*)(kp+4608);
  kf[6]=*(const __attribute__((address_space(3))) bf16x8*)(kp+6144); kf[7]=*(const __attribute__((address_space(3))) bf16x8*)(kp+6656);
}
__device__ __forceinline__ void kload2(bf16x8*kf,lds_cptr kp,int j){ kf[2*j]=*(const __attribute__((address_space(3))) bf16x8*)(kp+j*2048); kf[2*j+1]=*(const __attribute__((address_space(3))) bf16x8*)(kp+j*2048+512); }
__device__ __forceinline__ s16x4 vtr(lds_cptr p){ return __builtin_bit_cast(s16x4,__builtin_amdgcn_ds_read_tr16_b64_v4i16((__attribute__((address_space(3))) v4i16_t*)p)); }
__device__ __forceinline__ float rowmax(const f32x16&p0,const f32x16&p1){
  float a=max3f(p0[0],p0[1],p1[0]),b=max3f(p0[2],p0[3],p1[1]);a=max3f(a,p1[2],p1[3]);
  #pragma unroll
  for(int r=4;r<16;r+=4){a=max3f(a,p0[r],p0[r+1]);b=max3f(b,p0[r+2],p0[r+3]);a=max3f(a,p1[r],p1[r+1]);b=max3f(b,p1[r+2],p1[r+3]);}
  const float m=max2f(a,b);
  auto rr=__builtin_amdgcn_permlane32_swap(__float_as_uint(m),__float_as_uint(m),false,false);
  return max2f(__uint_as_float(rr[0]),__uint_as_float(rr[1]));
}
__device__ __forceinline__ void pv(f32x16*o,int vb,bf16x8 pa0,bf16x8 pa1,bf16x8 pa2,bf16x8 pa3){
  #pragma unroll
  for(int d0=0;d0<2;++d0){s16x4 lo[4],hi[4];
    #pragma unroll
    for(int ks=0;ks<4;++ks){
      asm volatile("ds_read_b64_tr_b16 %0,%1 offset:%c2":"=&v"(lo[ks]):"v"(vb),"i"(d0*4096+ks*1024):"memory");
      asm volatile("ds_read_b64_tr_b16 %0,%1 offset:%c2":"=&v"(hi[ks]):"v"(vb),"i"(d0*4096+ks*1024+512):"memory");}
    asm volatile("s_waitcnt lgkmcnt(0)":::"memory");SBAR();
    #define PK(k) (bf16x8){lo[k][0],lo[k][1],lo[k][2],lo[k][3],hi[k][0],hi[k][1],hi[k][2],hi[k][3]}
    o[d0]=__builtin_amdgcn_mfma_f32_32x32x16_bf16(pa0,PK(0),o[d0],0,0,0);
    o[d0]=__builtin_amdgcn_mfma_f32_32x32x16_bf16(pa1,PK(1),o[d0],0,0,0);
    o[d0]=__builtin_amdgcn_mfma_f32_32x32x16_bf16(pa2,PK(2),o[d0],0,0,0);
    o[d0]=__builtin_amdgcn_mfma_f32_32x32x16_bf16(pa3,PK(3),o[d0],0,0,0);
    #undef PK
  }
}

#ifndef ATTN_STORE16
#define ATTN_STORE16(p,v) (*(u32x4*)(p)=(v))
#endif
template<int THRL> __device__ __forceinline__ void attn_unit(int b,int h,int qb,const bf16*Q,const bf16*__restrict__ K,const bf16*__restrict__ V,bf16*O,const float*KM,char*shm){
  const int tid=threadIdx.x,lane=tid&63,r32=lane&31,hi=lane>>5; const int wid=__builtin_amdgcn_readfirstlane(tid>>6);
  const long rowbase=(long)b*SEQ; const int q0=qb*QB;
  const bf16*Qw=Q+(rowbase+q0+wid*QBLK)*DM+h*D;
  const bf16*Kh=K+rowbase*DM+h*D,*Vh=V+rowbase*DM+h*D;
  const unsigned lds0=(unsigned)(uintptr_t)shm;
  float*wsf=(float*)(shm+LDS_WS)+wid*64;
  const bf16*ksrc=Kh+(long)lane*DM+wid*8;
  const bf16*vsrc=Vh+(long)(16*(wid&3)+(lane>>2))*DM+(wid>>2)*32+(lane&3)*8;
  const unsigned kdst=lds0+LDS_K+wid*1024, vdst=lds0+LDS_V+wid*1024;
  #define PHYS(t) (((t)<4)?(NT-4+(t)):((t)-4))
  #define DMA_K(t,slot) glds16(ksrc+(long)PHYS(t)*KVBLK*DM,(unsigned)__builtin_amdgcn_readfirstlane(kdst+(slot)))
  #define DMA_V(t,slot) glds16(vsrc+(long)PHYS(t)*KVBLK*DM,(unsigned)__builtin_amdgcn_readfirstlane(vdst+(slot)))
  const int vb0=(int)(lds0+LDS_V)+((lane>>4)&1)*32+(lane&3)*8+(4*hi+((lane&15)>>2))*64;
  const char*Kbase=shm+LDS_K; bf16x8 kf[8];
  const lds_cptr shm3=(lds_cptr)shm; const lds_cptr kp0=shm3+LDS_K+hi*1024+r32*16; const lds_cptr vp0=shm3+LDS_V+((lane>>4)&1)*32+(lane&3)*8+(4*hi+((lane&15)>>2))*64;
  const int NT=(q0+QB)/KVBLK;
  DMA_K(0,0);DMA_V(0,0);DMA_K(1,SLOTB);
  bf16x8 qr[4];
  #pragma unroll
  for(int d0=0;d0<4;++d0)qr[d0]=*reinterpret_cast<const bf16x8*>(&Qw[(long)r32*DM+d0*16+hi*8]);
  int selmask=(1<<qb)-1;
  if(qb>3){
    float gt[7];
    #pragma unroll
    for(int kb=0;kb<7;++kb){ float a=0.f;
      if(kb<qb){ const float*km=KM+(((long)b*NHEAD+h)*8+kb)*64+hi*8;
        #pragma unroll
        for(int d0=0;d0<4;++d0){ const f32x4_t k0=*reinterpret_cast<const f32x4_t*>(km+d0*16), k1=*reinterpret_cast<const f32x4_t*>(km+d0*16+4);
          a+=bf2f(qr[d0][0])*k0[0]+bf2f(qr[d0][1])*k0[1]+bf2f(qr[d0][2])*k0[2]+bf2f(qr[d0][3])*k0[3]+bf2f(qr[d0][4])*k1[0]+bf2f(qr[d0][5])*k1[1]+bf2f(qr[d0][6])*k1[2]+bf2f(qr[d0][7])*k1[3]; } }
      a+=__shfl_xor(a,32); gt[kb]=a; }
    selmask=0;
    #pragma unroll
    for(int kb=0;kb<7;++kb){ int rank=0;
      #pragma unroll
      for(int k2=0;k2<7;++k2){ if(k2!=kb&&k2<qb){ rank+=((gt[k2]>gt[kb])||(gt[k2]==gt[kb]&&k2<kb))?1:0; } }
      if(kb<qb&&rank<3)selmask|=(1<<kb); }
  }
  float mhat=0.f,l_reg=0.f;f32x16 o[2];o[0]=f32x16{};o[1]=f32x16{};const f32x16 zc=f32x16{};
  const int qrel=wid*QBLK+r32;
  #define CMASK(P0,P1,t) do{int jb_=(t); if(jb_<4)cmask(P0,P1,jb_,qrel,hi); else if(!((selmask>>((jb_-4)>>2))&1)){ _Pragma("unroll") for(int r_=0;r_<16;++r_){P0[r_]=-INFINITY;P1[r_]=-INFINITY;} } }while(0)
  bool resc=false;
  #define START(P0,P1) do{ const float rm=rowmax(P0,P1); resc=false; \
    { const float dl=rm; mhat=fadd_s(mhat,dl); \
      _Pragma("unroll") for(int r=0;r<16;++r){P0[r]=fsub_s(P0[r],dl);P1[r]=fsub_s(P1[r],dl);} \
      } \
    _Pragma("unroll") for(int r=0;r<16;++r)P0[r]=__builtin_amdgcn_exp2f(P0[r]); }while(0)
  #define RESC() do{ if(resc){ asm volatile("s_waitcnt lgkmcnt(0)":::"memory"); \
      _Pragma("unroll") for(int d_=0;d_<2;++d_) _Pragma("unroll") for(int r=0;r<16;++r)o[d_][r]*=wsf[crow(r,hi)]; } }while(0)
  f32x16 pA0,pA1,pB0,pB1;
  int sl_prev=0,sl_cur=0,sl_next=SLOTB;
  #define ROT() do{sl_prev=sl_cur;sl_cur=sl_next;sl_next=(sl_next==(NSLOT-1)*SLOTB)?0:sl_next+SLOTB;}while(0)
  DMA_K(2,2*SLOTB);
  WAIT_BAR(3);
  qkt(pA0,pA1,Kbase,qr,zc,r32,hi);asm volatile("s_nop 15\n\ts_nop 7":"+v"(pA0),"+v"(pA1));CMASK(pA0,pA1,0);
  START(pA0,pA1);
  _Pragma("unroll") for(int r=0;r<16;++r)pA1[r]=__builtin_amdgcn_exp2f(pA1[r]);
  WAIT_BAR(0);
  DMA_K(3,0);DMA_V(1,SLOTB);
  ROT();
  kload8(kf,kp0+sl_cur);
  WAIT_BAR(2);
  s16x4 vlo[8],vhi[8]; u32x4 pw0,pw1,pw2,pw3;
  #define PKW(P,B) cvtpk_s(P[B],P[B+1])
  #define PAF(k) __builtin_bit_cast(bf16x8,pw##k)
  #define VFR(i) (bf16x8){vlo[i][0],vlo[i][1],vlo[i][2],vlo[i][3],vhi[i][0],vhi[i][1],vhi[i][2],vhi[i][3]}
  #define PIN(x) asm volatile("":"+v"(x))
  #define MX3(a,b,c) __builtin_fmaxf(__builtin_fmaxf((a),(b)),(c))
  #define GAPA(MF,A0,A1,A2,A3,W0,W1,PW) do{ MF; sacc+=A0; sacc+=A1; sacc+=A2; sacc+=A3; PIN(sacc); W0; W1; PIN(PW); SBAR(); }while(0)
  #define EX(v) __builtin_amdgcn_exp2f(v)
  #define GAPB(MF,X,B) do{ MF; X[B]=EX(X[B]-mhat); X[B+1]=EX(X[B+1]-mhat); X[B+2]=EX(X[B+2]-mhat); X[B+3]=EX(X[B+3]-mhat); PIN(X); SBAR(); }while(0)
  #define VRD(i) do{ vlo[i]=vtr(vp_+(((i)>>2)*4096+((i)&3)*1024)); vhi[i]=vtr(vp_+(((i)>>2)*4096+((i)&3)*1024+512)); }while(0)
  #define KRD(G,j) do{ if(G){ kload2(kf,kp0+sl_next,j); SBAR(); } }while(0)
  #define STEP(C0,C1,P0,P1,t,GK,GV,GL) do{ SBAR(); \
    const lds_cptr vp_=vp0+sl_prev; \
    VRD(0); SBAR(); float sacc=(P0[0]+P0[1]); \
    GAPA(C0=__builtin_amdgcn_mfma_f32_32x32x16_bf16(kf[0],qr[0],zc,0,0,0), P0[2],P0[3],P0[4],P0[5],     pw0[0]=PKW(P0,0), pw0[1]=PKW(P0,2), pw0); \
    VRD(4); SBAR(); GAPA(C1=__builtin_amdgcn_mfma_f32_32x32x16_bf16(kf[1],qr[0],zc,0,0,0), P0[6],P0[7],P0[8],P0[9],     pw0[2]=PKW(P0,4), pw0[3]=PKW(P0,6), pw0); \
    VRD(1); SBAR(); GAPA(C0=__builtin_amdgcn_mfma_f32_32x32x16_bf16(kf[2],qr[1],C0,0,0,0),   P0[10],P0[11],P0[12],P0[13], pw1[0]=PKW(P0,8), pw1[1]=PKW(P0,10), pw1); \
    VRD(5); SBAR(); GAPA(C1=__builtin_amdgcn_mfma_f32_32x32x16_bf16(kf[3],qr[1],C1,0,0,0),   P0[14],P0[15],P1[0],P1[1],   pw1[2]=PKW(P0,12),pw1[3]=PKW(P0,14), pw1); \
    VRD(2); SBAR(); GAPA(C0=__builtin_amdgcn_mfma_f32_32x32x16_bf16(kf[4],qr[2],C0,0,0,0),   P1[2],P1[3],P1[4],P1[5],     pw2[0]=PKW(P1,0), pw2[1]=PKW(P1,2), pw2); \
    VRD(6); SBAR(); GAPA(C1=__builtin_amdgcn_mfma_f32_32x32x16_bf16(kf[5],qr[2],C1,0,0,0),   P1[6],P1[7],P1[8],P1[9],     pw2[2]=PKW(P1,4), pw2[3]=PKW(P1,6), pw2); \
    VRD(3); SBAR(); GAPA(C0=__builtin_amdgcn_mfma_f32_32x32x16_bf16(kf[6],qr[3],C0,0,0,0),   P1[10],P1[11],P1[12],P1[13], pw3[0]=PKW(P1,8), pw3[1]=PKW(P1,10), pw3); \
    VRD(7); SBAR(); GAPA(C1=__builtin_amdgcn_mfma_f32_32x32x16_bf16(kf[7],qr[3],C1,0,0,0),   P1[14],P1[15],0.f,0.f,       pw3[2]=PKW(P1,12),pw3[3]=PKW(P1,14), pw3); \
    l_reg+=sacc; \
    if(GK){DMA_K((t)+3,sl_cur);} if(GV){DMA_V((t)+1,sl_next);} \
    CMASK(C0,C1,t); \
    { float a=MX3(C0[0],C0[1],C1[0]),b=MX3(C0[2],C0[3],C1[1]); a=MX3(a,C1[2],C1[3]); \
      _Pragma("unroll") for(int r=4;r<16;r+=4){a=MX3(a,C0[r],C0[r+1]);b=MX3(b,C0[r+2],C0[r+3]);a=MX3(a,C1[r],C1[r+1]);b=MX3(b,C1[r+2],C1[r+3]);} \
      float rm=__builtin_fmaxf(a,b); { auto rr=__builtin_amdgcn_permlane32_swap(__float_as_uint(rm),__float_as_uint(rm),false,false); rm=__builtin_fmaxf(__uint_as_float(rr[0]),__uint_as_float(rr[1])); } \
      rm-=mhat; resc=false; \
      if(__builtin_expect(__any(rm>(float)THRL),0)){ const float dl=__builtin_fmaxf(rm,0.f); mhat+=dl; \
        const float f=__builtin_amdgcn_exp2f(-dl); l_reg*=f; if(hi==0)wsf[r32]=f; resc=true; } } \
    SBAR(); \
    GAPB(o[0]=__builtin_amdgcn_mfma_f32_32x32x16_bf16(PAF(0),VFR(0),o[0],0,0,0), C0,0); \
    GAPB(o[1]=__builtin_amdgcn_mfma_f32_32x32x16_bf16(PAF(0),VFR(4),o[1],0,0,0), C0,4); \
    KRD(GL,0); GAPB(o[0]=__builtin_amdgcn_mfma_f32_32x32x16_bf16(PAF(1),VFR(1),o[0],0,0,0), C0,8); \
    KRD(GL,1); GAPB(o[1]=__builtin_amdgcn_mfma_f32_32x32x16_bf16(PAF(1),VFR(5),o[1],0,0,0), C0,12); \
    KRD(GL,2); GAPB(o[0]=__builtin_amdgcn_mfma_f32_32x32x16_bf16(PAF(2),VFR(2),o[0],0,0,0), C1,0); \
    KRD(GL,3); GAPB(o[1]=__builtin_amdgcn_mfma_f32_32x32x16_bf16(PAF(2),VFR(6),o[1],0,0,0), C1,4); \
    GAPB(o[0]=__builtin_amdgcn_mfma_f32_32x32x16_bf16(PAF(3),VFR(3),o[0],0,0,0), C1,8); \
    GAPB(o[1]=__builtin_amdgcn_mfma_f32_32x32x16_bf16(PAF(3),VFR(7),o[1],0,0,0), C1,12); \
    }while(0)
  int t=1;
  #undef CMASK
  #define CMASK(P0,P1,t) do{int jb_=(t); if(jb_<4)cmask(P0,P1,jb_,qrel,hi); else if(!((selmask>>((jb_-4)>>2))&1)){ _Pragma("unroll") for(int r_=0;r_<16;++r_){P0[r_]=-INFINITY;P1[r_]=-INFINITY;} } }while(0)
  #define ENDW(tt) do{ if((tt)+3<NT){WAIT_BAR(2);} else if((tt)+2<NT){WAIT_BAR(1);} else {WAIT_BAR(0);} }while(0)
  for(;t+1<NT;t+=2){
    STEP(pB0,pB1,pA0,pA1,t,(t+3<NT),(t+1<NT),(t+1<NT));       ENDW(t);   RESC(); ROT();
    STEP(pA0,pA1,pB0,pB1,t+1,(t+4<NT),(t+2<NT),(t+2<NT));     ENDW(t+1); RESC(); ROT();
  }
  STEP(pB0,pB1,pA0,pA1,NT-1,false,false,false); RESC();
  { float sacc=pB0[0]+pB0[1]; _Pragma("unroll") for(int r=2;r<16;++r)sacc+=pB0[r]; _Pragma("unroll") for(int r=0;r<16;++r)sacc+=pB1[r]; l_reg+=sacc;
    pw0=(u32x4){PKW(pB0,0),PKW(pB0,2),PKW(pB0,4),PKW(pB0,6)};pw1=(u32x4){PKW(pB0,8),PKW(pB0,10),PKW(pB0,12),PKW(pB0,14)};pw2=(u32x4){PKW(pB1,0),PKW(pB1,2),PKW(pB1,4),PKW(pB1,6)};pw3=(u32x4){PKW(pB1,8),PKW(pB1,10),PKW(pB1,12),PKW(pB1,14)};
    SBAR(); pv(o,vb0+sl_cur,PAF(0),PAF(1),PAF(2),PAF(3)); }
  #undef PKW
  #undef PAF
  #undef VFR
  #undef PIN
  #undef MX3
  #undef GAPA
  #undef GAPB
  #undef EX
  #undef VRD
  #undef KRD
  #undef STEP
  #undef ENDW
  {auto rr=__builtin_amdgcn_permlane32_swap(__float_as_uint(l_reg),__float_as_uint(l_reg),false,false);l_reg=__uint_as_float(rr[0])+__uint_as_float(rr[1]);}
  if(hi==0)wsf[32+r32]=l_reg;asm volatile("s_waitcnt lgkmcnt(0)":::"memory");
  float rli[16];
  #pragma unroll
  for(int r=0;r<16;++r)rli[r]=__builtin_amdgcn_rcpf(wsf[32+crow(r,hi)]);
  bf16*Ow=O+(rowbase+q0+wid*QBLK)*DM+h*D;
  { bf16*stg=(bf16*)(shm+LDS_OST)+wid*2048;
    #pragma unroll
    for(int r=0;r<16;++r){const int orow=crow(r,hi);
      #pragma unroll
      for(int d0=0;d0<2;++d0)stg[orow*64+d0*32+r32]=__float2bfloat16(o[d0][r]*rli[r]);}
    asm volatile("s_waitcnt lgkmcnt(0)":::"memory");
    #pragma unroll
    for(int i=0;i<4;++i){const int row=i*8+(lane>>3),ch=lane&7; const u32x4 v=*(const u32x4*)(stg+row*64+ch*8); ATTN_STORE16(Ow+(long)row*DM+ch*8,v);} }
  asm volatile("s_waitcnt lgkmcnt(0)\n\ts_barrier":::"memory");
  #undef DMA_K
  #undef PHYS
  #undef DMA_V
  #undef CMASK
  #undef START
  #undef RESC
  #undef ROT
}
constexpr int ATTN_LDS_BYTES=LDS_BYTES;
struct AttnTensors { const bf16* Q; const bf16* K; const bf16* V; bf16* O; const float* KM; };
struct AttnUnit { int bh; int qb; };
struct StaticOrder {
  int vcu,G;
  __device__ __forceinline__ explicit StaticOrder(int grid,int block):vcu((grid%8==0)?(block%8)*(grid/8)+block/8:block),G(grid){}
  __device__ __forceinline__ bool next(int i,AttnUnit&u)const{ const int idx=i*G+vcu; if(idx>=1024)return false; const int v=idx&255,j=idx>>8; u.bh=v>>1;
    const int s=(v&1); u.qb=(j==0)?s:(j==1)?7-s:(j==2)?3-s:4+s; return true; }
  __device__ __forceinline__ void a_ready(const AttnUnit&)const{}
  __device__ __forceinline__ void done(const AttnUnit&)const{}
};
template<class Sched,int THRL=8> __device__ __forceinline__ void attn_phase(char*lds,const AttnTensors&T,const Sched&S){
  AttnUnit u;
  for(int i=0;S.next(i,u);++i){ S.a_ready(u); attn_unit<THRL>(u.bh/NHEAD,u.bh%NHEAD,u.qb,T.Q,T.K,T.V,T.O,T.KM,lds); S.done(u); }
}
#undef SBAR
#undef WAIT_BAR
}
struct Args { const float* in[29]; float* out; unsigned char* ws; int ph_lo, ph_hi, li, pad; };
typedef const __attribute__((address_space(4))) Args* ArgsP;
__device__ __forceinline__ ArgsP fresh_args() { ArgsP p = (ArgsP)__builtin_amdgcn_kernarg_segment_ptr(); asm volatile("" : "+s"(p)); return p; }

struct Frame {
    LAS unsigned char* lds;
    volatile LAS unsigned* MISC;
    gu32* ctl;
    int tid, lane, wave, vcu, G;
};

__device__ __forceinline__ void conv_item(const float* W, int N, bf16_t* WT, int Kd, int dst_row0, int k0, int n0, LAS float* scr, int lane) {
#pragma unroll 8
    for (int i = 0; i < 32; ++i) { const int kk = 2 * i + (lane >> 5); scr[kk * 33 + (lane & 31)] = W[(size_t)(k0 + kk) * N + n0 + (lane & 31)]; }
    LDS_WAIT(); asm volatile("" ::: "memory");
    const int c = lane & 7;
#pragma unroll
    for (int j = 0; j < 4; ++j) { const int n = (lane >> 3) + 8 * j; const LAS float* s = scr + (8 * c) * 33 + n;
        u32x4 o; o.x = pk2(s[0 * 33], s[1 * 33]); o.y = pk2(s[2 * 33], s[3 * 33]); o.z = pk2(s[4 * 33], s[5 * 33]); o.w = pk2(s[6 * 33], s[7 * 33]);
        *(u32x4*)(WT + (size_t)(dst_row0 + n) * Kd + k0 + 8 * c) = o; }
    LDS_WAIT(); asm volatile("" ::: "memory");
}
__device__ __forceinline__ void conv_moe_layer(const Frame& F, ArgsP a, int layer, bf16_t* GU, bf16_t* DN, LAS float* scr) {
    const int gw = F.vcu * NWAVES + F.wave, NGW = F.G * NWAVES;
    constexpr int PER_E = 384, NIT = 65 * PER_E;
    for (int it = gw; it < NIT; it += NGW) {
        const int e = it / PER_E, r = it % PER_E, which = r >> 7, q = r & 127;
        const float* src;
        if (e < 64) src = a->in[22 + which] + (size_t)(layer * 64 + e) * (1024 * 256);
        else src = a->in[25 + which] + (size_t)layer * (1024 * 256);
        if (which < 2) { const int kb = q >> 3, nb = q & 7, n0 = nb * 32;
            conv_item(src, 256, GU, 1024, e * 512 + (n0 >> 7) * 256 + which * 128 + (n0 & 127), kb * 64, n0, scr, F.lane);
        } else { const int kb = q >> 5, nb = q & 31, n0 = nb * 32;
            conv_item(src, 1024, DN, 256, e * 1024 + n0, kb * 64, n0, scr, F.lane); }
    }
}
__device__ __forceinline__ void conv_dense(const Frame& F, const float* W, int K, int N, bf16_t* WT, LAS float* scr) {
    const int gw = F.vcu * NWAVES + F.wave, NGW = F.G * NWAVES;
    const int nblk = N / 32, nit = (K / 64) * nblk;
    for (int it = gw; it < nit; it += NGW) { const int kb = it / nblk, nb = it % nblk; conv_item(W, N, WT, K, nb * 32, kb * 64, nb * 32, scr, F.lane); }
}

__device__ __forceinline__ void row_load(const float* row, int lane, float (&v)[16]) {
#pragma unroll
    for (int jj = 0; jj < 2; ++jj) { const f32x4 a = *(const f32x4*)(row + 8 * lane + 512 * jj), b = *(const f32x4*)(row + 8 * lane + 512 * jj + 4);
#pragma unroll
        for (int j = 0; j < 4; ++j) { v[8 * jj + j] = a[j]; v[8 * jj + 4 + j] = b[j]; } }
}
__device__ __forceinline__ void row_store(float* row, int lane, const float (&v)[16]) {
#pragma unroll
    for (int jj = 0; jj < 2; ++jj) { *(f32x4*)(row + 8 * lane + 512 * jj) = (f32x4){v[8 * jj], v[8 * jj + 1], v[8 * jj + 2], v[8 * jj + 3]}; *(f32x4*)(row + 8 * lane + 512 * jj + 4) = (f32x4){v[8 * jj + 4], v[8 * jj + 5], v[8 * jj + 6], v[8 * jj + 7]}; }
}
__device__ __forceinline__ float row_rstd(const float (&v)[16]) {
    float s = 0.f;
#pragma unroll
    for (int j = 0; j < 16; ++j) s += v[j] * v[j];
    return rsqrtf(wave_sum(s) * (1.0f / D) + RMS_EPS);
}
__device__ __forceinline__ void row_mod(const float (&v)[16], float rstd, const float* g, const float* shift, const float* scale, int lane, float (&h)[16]) {
    float gg[16], sh[16], sc[16];
    row_load(g, lane, gg); row_load(shift, lane, sh); row_load(scale, lane, sc);
#pragma unroll
    for (int j = 0; j < 16; ++j) h[j] = (v[j] * rstd * gg[j]) * (1.0f + sc[j]) + sh[j];
}
__device__ __forceinline__ void row_store_bf16(bf16_t* row, int lane, const float (&h)[16]) {
#pragma unroll
    for (int jj = 0; jj < 2; ++jj) { u32x4 w; w.x = pk2(h[8 * jj], h[8 * jj + 1]); w.y = pk2(h[8 * jj + 2], h[8 * jj + 3]); w.z = pk2(h[8 * jj + 4], h[8 * jj + 5]); w.w = pk2(h[8 * jj + 6], h[8 * jj + 7]);
        *(u32x4*)(row + 8 * lane + 512 * jj) = w; }
}
__device__ __forceinline__ void row_add_y(float (&v)[16], const bf16_t* y, const float* gate, int lane) {
    float s[16];
#pragma unroll
    for (int j = 0; j < 16; ++j) s[j] = 0.f;
#pragma unroll
    for (int k = 0; k < TOPK; ++k)
#pragma unroll
        for (int jj = 0; jj < 2; ++jj) { const u32x4 w = *(const u32x4*)(y + (size_t)k * D + 8 * lane + 512 * jj);
            s[8 * jj + 0] += bf_lo(w.x); s[8 * jj + 1] += bf_hi(w.x); s[8 * jj + 2] += bf_lo(w.y); s[8 * jj + 3] += bf_hi(w.y);
            s[8 * jj + 4] += bf_lo(w.z); s[8 * jj + 5] += bf_hi(w.z); s[8 * jj + 6] += bf_lo(w.w); s[8 * jj + 7] += bf_hi(w.w); }
    float gg[16]; row_load(gate, lane, gg);
#pragma unroll
    for (int j = 0; j < 16; ++j) v[j] += gg[j] * s[j];
}

__device__ __forceinline__ void phase_p0(const Frame& F, ArgsP a) {
    unsigned char* ws = a->ws;
    if ((int)blockIdx.x < 224) {
        LAS float* sc = (LAS float*)F.lds;
        LAS float* red = (LAS float*)(F.lds + 32768);
        const float* c = a->in[1];
        for (int i = F.tid; i < 8 * 1024; i += NTHREADS) sc[i] = silu_f(c[i]);
        __syncthreads();
        const int cg = blockIdx.x;
        const float* W; const float* bias; float* out; int N, n0;
        if (cg < 96) { W = a->in[2]; bias = a->in[3]; out = (float*)(ws + WS_MOD); N = 6144; n0 = cg * 64; }
        else if (cg < 192) { W = a->in[2] + (size_t)1024 * 6144; bias = a->in[3] + 6144; out = (float*)(ws + WS_MOD) + MOD_L; N = 6144; n0 = (cg - 96) * 64; }
        else { W = a->in[14]; bias = a->in[15]; out = (float*)(ws + WS_MOD) + 2 * MOD_L; N = 2048; n0 = (cg - 192) * 64; }
        float acc[8];
#pragma unroll
        for (int b = 0; b < 8; ++b) acc[b] = 0.f;
        const int k0 = F.wave * 128;
#pragma unroll 4
        for (int kk = 0; kk < 128; kk += 4) {
            float w[4];
#pragma unroll
            for (int i = 0; i < 4; ++i) w[i] = W[(size_t)(k0 + kk + i) * N + n0 + F.lane];
#pragma unroll
            for (int b = 0; b < 8; ++b) { const f32x4 s = *(const LAS f32x4*)(sc + b * 1024 + k0 + kk); acc[b] += s[0] * w[0]; acc[b] += s[1] * w[1]; acc[b] += s[2] * w[2]; acc[b] += s[3] * w[3]; }
        }
#pragma unroll
        for (int b = 0; b < 8; ++b) red[(F.wave * 8 + b) * 64 + F.lane] = acc[b];
        __syncthreads();
        { const int b = F.tid >> 6, l = F.tid & 63; float s = 0.f;
#pragma unroll
            for (int w = 0; w < 8; ++w) s += red[(w * 8 + b) * 64 + l];
            out[(size_t)b * N + n0 + l] = s + bias[n0 + l]; }
        __syncthreads();
    }
    LAS float* scr = (LAS float*)(F.lds + F.wave * 16384);
    conv_dense(F, a->in[6], 1024, 4096, (bf16_t*)(ws + WS_WIN_T), scr);
    conv_dense(F, a->in[12], 2048, 1024, (bf16_t*)(ws + WS_WOUT_T), scr);
    conv_dense(F, a->in[18], 1024, 1024, (bf16_t*)(ws + WS_WQKV_T), scr);
    conv_dense(F, a->in[16], 1024, 1024, (bf16_t*)(ws + WS_WQKV_T) + (size_t)1024 * 1024, scr);
    conv_dense(F, a->in[17], 1024, 1024, (bf16_t*)(ws + WS_WQKV_T) + (size_t)2048 * 1024, scr);
    conv_dense(F, a->in[19], 1024, 1024, (bf16_t*)(ws + WS_WO_T), scr);
    conv_moe_layer(F, a, 0, (bf16_t*)(ws + WS_GU), (bf16_t*)(ws + WS_DN), scr);
    { const float* wr = a->in[20]; bf16_t* o = (bf16_t*)(ws + WS_WR);
      for (int i = blockIdx.x * NTHREADS + F.tid; i < 2 * NE * D; i += F.G * NTHREADS) { const int L = i >> 16, e = (i >> 10) & 63, d = i & 1023;
          const float w = wr[((size_t)L * D + d) * NE + e]; const unsigned hi = f2bf(w); const float rem = w - __uint_as_float(hi << 16);
          o[(size_t)L * 2 * NE * D + (size_t)e * D + d] = (bf16_t)hi; o[(size_t)L * 2 * NE * D + (size_t)NE * D + (size_t)e * D + d] = (bf16_t)f2bf(rem); } }
    { const float* wsp = a->in[10]; bf16_t* o = (bf16_t*)(ws + WS_WSP);
      for (int i = blockIdx.x * NTHREADS + F.tid; i < 8 * 128 * 128; i += F.G * NTHREADS) { const int t = (i >> 7) & 127, s = i & 127; o[i] = (bf16_t)(s <= t ? f2bf(wsp[i]) : 0u); } }
}

__device__ __forceinline__ void phase_p1(const Frame& F, ArgsP a) {
    const int gw = blockIdx.x * NWAVES + F.wave, NGW = F.G * NWAVES;
    const float* mod = (const float*)(a->ws + WS_MOD);
    bf16_t* hA = (bf16_t*)(a->ws + WS_SCR);
    for (int m = gw; m < T; m += NGW) {
        const int b = m / SEQ; float v[16], h[16];
        row_load(a->in[0] + (size_t)m * D, F.lane, v);
        const float rstd = row_rstd(v);
        row_mod(v, rstd, a->in[4], mod + (size_t)b * 6144, mod + (size_t)b * 6144 + 1024, F.lane, h);
        row_store_bf16(hA + (size_t)m * D, F.lane, h);
    }
}

__device__ __forceinline__ void phase_p3(const Frame& F, ArgsP a) {
    bf16_t* U = (bf16_t*)(a->ws + WS_SCR + 64 * MiB); const bf16_t* VT = (const bf16_t*)(a->ws + WS_SCR + 128 * MiB);
    const bf16_t* Wsp = (const bf16_t*)(a->ws + WS_WSP); const float* vpart = (const float*)(a->ws + WS_VPART);
    const float* lng = a->in[8]; const float* lnb = a->in[9]; const float* bsp = a->in[11];
    LAS float* mu = (LAS float*)F.lds; LAS float* rs = mu + 128;
    const int fr = F.lane & 15, fq = F.lane >> 4;
    for (int item = blockIdx.x; item < 256; item += F.G) {
        const int chunk = item >> 1, g0 = (item & 1) * 4;
        __syncthreads();
        if (F.tid < 128) { const float* p = vpart + (size_t)(chunk * 128 + F.tid) * 64; float s1 = 0.f, s2 = 0.f;
            for (int j = 0; j < 32; ++j) { s1 += p[2 * j]; s2 += p[2 * j + 1]; }
            const float mean = s1 * (1.0f / AW), var = s2 * (1.0f / AW) - mean * mean; mu[F.tid] = mean; rs[F.tid] = rsqrtf(var + LN_EPS); }
        __syncthreads();
        for (int gi = 0; gi < 4; ++gi) {
            const int g = g0 + gi;
            f32x4 acc[2][8];
#pragma unroll
            for (int dt = 0; dt < 2; ++dt)
#pragma unroll
                for (int tt = 0; tt < 8; ++tt) acc[dt][tt] = (f32x4){0.f, 0.f, 0.f, 0.f};
            bf16x8 af[2][4];
#pragma unroll
            for (int dt = 0; dt < 2; ++dt) {
                const int col = g * 256 + 32 * F.wave + 16 * dt + fr; const float lg = lng[col], lb = lnb[col];
#pragma unroll
                for (int ks = 0; ks < 4; ++ks) {
                    const int s0 = 32 * ks + 8 * fq;
                    const u32x4 raw = *(const u32x4*)(VT + ((size_t)chunk * AW + col) * 128 + s0);
                    const f32x4 m0 = *(const LAS f32x4*)(mu + s0), m1 = *(const LAS f32x4*)(mu + s0 + 4), r0 = *(const LAS f32x4*)(rs + s0), r1 = *(const LAS f32x4*)(rs + s0 + 4);
                    float x[8] = {bf_lo(raw.x), bf_hi(raw.x), bf_lo(raw.y), bf_hi(raw.y), bf_lo(raw.z), bf_hi(raw.z), bf_lo(raw.w), bf_hi(raw.w)};
#pragma unroll
                    for (int j = 0; j < 4; ++j) { x[j] = (x[j] - m0[j]) * r0[j] * lg + lb; x[4 + j] = (x[4 + j] - m1[j]) * r1[j] * lg + lb; }
                    u32x4 o; o.x = pk2(x[0], x[1]); o.y = pk2(x[2], x[3]); o.z = pk2(x[4], x[5]); o.w = pk2(x[6], x[7]);
                    af[dt][ks] = __builtin_bit_cast(bf16x8, o);
                }
            }
#pragma unroll
            for (int tt = 0; tt < 8; ++tt)
#pragma unroll
                for (int ks = 0; ks < 4; ++ks) if (2 * ks <= tt) {
                    const bf16x8 bw = *(const bf16x8*)(Wsp + ((size_t)g * 128 + 16 * tt + fr) * 128 + 32 * ks + 8 * fq);
#pragma unroll
                    for (int dt = 0; dt < 2; ++dt) acc[dt][tt] = __builtin_amdgcn_mfma_f32_16x16x32_bf16(af[dt][ks], bw, acc[dt][tt], 0, 0, 0);
                }
#pragma unroll
            for (int tt = 0; tt < 8; ++tt) {
                const int t = 16 * tt + fr; const float bs = bsp[g * 128 + t];
#pragma unroll
                for (int dt = 0; dt < 2; ++dt) {
                    bf16_t* up = U + (size_t)(chunk * 128 + t) * AW + g * 256 + 32 * F.wave + 16 * dt + 4 * fq;
                    const u32x2 uu = *(const u32x2*)up; const f32x4 sv = acc[dt][tt] + bs;
                    u32x2 o; o.x = pk2(bf_lo(uu.x) * sv[0], bf_hi(uu.x) * sv[1]); o.y = pk2(bf_lo(uu.y) * sv[2], bf_hi(uu.y) * sv[3]);
                    *(u32x2*)up = o;
                }
            }
        }
    }
}

typedef float f32x16 __attribute__((ext_vector_type(16)));
__device__ __forceinline__ void phase_router(const Frame& F, ArgsP a, int layer) {
    const float* X = a->out; bf16_t* hA = (bf16_t*)(a->ws + WS_SCR);
    const float* mod = (const float*)(a->ws + WS_MOD) + (size_t)layer * MOD_L;
    const float* nw = a->in[5] + layer * D; const float* eb = a->in[21] + layer * NE;
    const bf16_t* Whi = (const bf16_t*)(a->ws + WS_WR) + (size_t)layer * 2 * NE * D; const bf16_t* Wlo = Whi + (size_t)NE * D;
    int* toklist = (int*)(a->ws + WS_TOKLIST); float* wlist = (float*)(a->ws + WS_WLIST);
    unsigned* cnt = (unsigned*)(a->ws + WS_CTL) + CW_CNT + layer * 64;
    LAS unsigned char* Ahi = F.lds; LAS unsigned char* Alo = F.lds + 65536; LAS float* part = (LAS float*)F.lds;
    LAS int* sel_e = (LAS int*)(F.lds + LDS_AUX); LAS float* sel_w = (LAS float*)(sel_e + 512); LAS int* sel_li = (LAS int*)(sel_w + 512);
    LAS int* hist = sel_li + 512; LAS int* gbase = hist + 64;
    const int l31 = F.lane & 31, lh = F.lane >> 5;
    for (int grp = blockIdx.x; grp < T / 64; grp += F.G) {
        __syncthreads();
        if (F.tid < 64) hist[F.tid] = 0;
        for (int rd = 0; rd < 2; ++rd) {
            __syncthreads();
#pragma unroll 2
            for (int j = 0; j < 4; ++j) {
                const int r = F.wave * 4 + j, t = grp * 64 + rd * 32 + r, b = t / SEQ; float v[16], h[16];
                row_load(X + (size_t)t * D, F.lane, v);
                const float rstd = row_rstd(v);
                row_mod(v, rstd, nw, mod + (size_t)b * 6144 + 3072, mod + (size_t)b * 6144 + 4096, F.lane, h);
                unsigned hi[8], lo[8];
#pragma unroll
                for (int q = 0; q < 8; ++q) { hi[q] = pk2(h[2 * q], h[2 * q + 1]); lo[q] = pk2(h[2 * q] - bf_lo(hi[q]), h[2 * q + 1] - bf_hi(hi[q])); }
#pragma unroll
                for (int jj = 0; jj < 2; ++jj) {
                    const u32x4 wh = {hi[4 * jj], hi[4 * jj + 1], hi[4 * jj + 2], hi[4 * jj + 3]}, wl = {lo[4 * jj], lo[4 * jj + 1], lo[4 * jj + 2], lo[4 * jj + 3]};
                    *(u32x4*)(hA + (size_t)t * D + 8 * F.lane + 512 * jj) = wh;
                    const int c = (F.lane + 64 * jj) ^ (r & 15);
                    *(LAS u32x4*)(Ahi + r * 2048 + c * 16) = wh; *(LAS u32x4*)(Alo + r * 2048 + c * 16) = wl;
                }
            }
            __syncthreads();
            f32x16 acc0 = {0.f}, acc1 = {0.f};
#pragma unroll
            for (int ks = 0; ks < 8; ++ks) {
                const int k0 = 128 * F.wave + 16 * ks + 8 * lh, c = (k0 >> 3) ^ (l31 & 15);
                const bf16x8 ah = *(const LAS bf16x8*)(Ahi + l31 * 2048 + c * 16), al = *(const LAS bf16x8*)(Alo + l31 * 2048 + c * 16);
                const bf16x8 bh0 = *(const bf16x8*)(Whi + (size_t)l31 * D + k0), bl0 = *(const bf16x8*)(Wlo + (size_t)l31 * D + k0);
                const bf16x8 bh1 = *(const bf16x8*)(Whi + (size_t)(l31 + 32) * D + k0), bl1 = *(const bf16x8*)(Wlo + (size_t)(l31 + 32) * D + k0);
                acc0 = __builtin_amdgcn_mfma_f32_32x32x16_bf16(ah, bh0, acc0, 0, 0, 0); acc1 = __builtin_amdgcn_mfma_f32_32x32x16_bf16(ah, bh1, acc1, 0, 0, 0);
                acc0 = __builtin_amdgcn_mfma_f32_32x32x16_bf16(ah, bl0, acc0, 0, 0, 0); acc1 = __builtin_amdgcn_mfma_f32_32x32x16_bf16(ah, bl1, acc1, 0, 0, 0);
                acc0 = __builtin_amdgcn_mfma_f32_32x32x16_bf16(al, bh0, acc0, 0, 0, 0); acc1 = __builtin_amdgcn_mfma_f32_32x32x16_bf16(al, bh1, acc1, 0, 0, 0);
            }
            __syncthreads();
#pragma unroll
            for (int rg = 0; rg < 16; ++rg) { const int i = (rg & 3) + 8 * (rg >> 2) + 4 * lh;
                part[(F.wave * 32 + i) * 64 + l31] = acc0[rg]; part[(F.wave * 32 + i) * 64 + 32 + l31] = acc1[rg]; }
            __syncthreads();
            const float bias = eb[F.lane];
#pragma unroll
            for (int j = 0; j < 4; ++j) {
                const int r = F.wave * 4 + j;
                float lg = 0.f;
#pragma unroll
                for (int w = 0; w < 8; ++w) lg += part[(w * 32 + r) * 64 + F.lane];
                const float score = 1.0f / (1.0f + __expf(-lg)), choice = score + bias;
                float m1 = choice; m1 = fmaxf(m1, __shfl_xor(m1, 1)); m1 = fmaxf(m1, __shfl_xor(m1, 2)); m1 = fmaxf(m1, __shfl_xor(m1, 4));
                int idx = (choice == m1) ? (F.lane & 7) : 8; idx = min(idx, __shfl_xor(idx, 1)); idx = min(idx, __shfl_xor(idx, 2)); idx = min(idx, __shfl_xor(idx, 4));
                float m2 = ((F.lane & 7) == idx) ? -INFINITY : choice; m2 = fmaxf(m2, __shfl_xor(m2, 1)); m2 = fmaxf(m2, __shfl_xor(m2, 2)); m2 = fmaxf(m2, __shfl_xor(m2, 4));
                const float gs = m1 + m2; const int g = F.lane >> 3;
                int grank = 0;
#pragma unroll
                for (int g2 = 0; g2 < 8; ++g2) { const float o = __shfl(gs, g2 * 8); grank += ((o > gs) || (o == gs && g2 < g)) ? 1 : 0; }
                const float cm = (grank < 4) ? choice : -1e30f;
                int rank = 0;
#pragma unroll
                for (int e2 = 0; e2 < 64; ++e2) { const float o = __shfl(cm, e2); rank += ((o > cm) || (o == cm && e2 < F.lane)) ? 1 : 0; }
                const bool sel = rank < TOPK;
                const float wsum = wave_sum(sel ? score : 0.f);
                const float w = score / wsum * ROUTED_SCALE;
                const unsigned long long bal = __ballot(sel);
                if (sel) { const int k = __popcll(bal & ((1ull << F.lane) - 1ull)); const int tl = rd * 32 + r;
                    sel_e[tl * 8 + k] = F.lane; sel_w[tl * 8 + k] = w; sel_li[tl * 8 + k] = __hip_atomic_fetch_add(&hist[F.lane], 1, __ATOMIC_RELAXED, __HIP_MEMORY_SCOPE_WORKGROUP); }
            }
        }
        __syncthreads();
        if (F.tid < 64) gbase[F.tid] = (int)__hip_atomic_fetch_add(cnt + F.tid, (unsigned)hist[F.tid], RLX_AGENT);
        __syncthreads();
        { const int p = F.tid, e = sel_e[p], pos = gbase[e] + sel_li[p];
          toklist[(size_t)e * CAP + pos] = (grp * 64 + (p >> 3)) * 8 + (p & 7); wlist[(size_t)e * CAP + pos] = sel_w[p]; }
    }
}

__device__ __forceinline__ void moe_tables(const Frame& F, ArgsP a, int layer, LAS int* cntl, LAS int* tb) {
    const unsigned* cnt = (const unsigned*)(a->ws + WS_CTL) + CW_CNT + layer * 64;
    __syncthreads();
    if (F.tid < 64) cntl[F.tid] = (int)__hip_atomic_load(cnt + F.tid, RLX_AGENT);
    __syncthreads();
    if (F.tid == 0) { int s = 0; for (int e = 0; e < 64; ++e) { tb[e] = s; s += (cntl[e] + 255) >> 8; } tb[64] = s; tb[65] = s + T / 256; }
    __syncthreads();
}

__device__ __forceinline__ void phase_p8(const Frame& F, ArgsP a) {
    const int gw = blockIdx.x * NWAVES + F.wave, NGW = F.G * NWAVES;
    const float* mod0 = (const float*)(a->ws + WS_MOD); const float* mod1 = mod0 + MOD_L; const float* modkv = mod0 + 2 * MOD_L;
    float* X = a->out; const bf16_t* Y = (const bf16_t*)(a->ws + WS_SCR); bf16_t* hB = (bf16_t*)(a->ws + WS_H);
    for (int m = gw; m < T; m += NGW) {
        const int b = m / SEQ; float v[16], h[16];
        row_load(X + (size_t)m * D, F.lane, v);
        row_add_y(v, Y + (size_t)m * TOPK * D, mod0 + (size_t)b * 6144 + 5120, F.lane);
        row_store(X + (size_t)m * D, F.lane, v);
        const float rstd = row_rstd(v);
        row_mod(v, rstd, a->in[4] + D, mod1 + (size_t)b * 6144, mod1 + (size_t)b * 6144 + 1024, F.lane, h);
        row_store_bf16(hB + (size_t)m * D, F.lane, h);
        row_mod(v, rstd, a->in[13], modkv + (size_t)b * 2048, modkv + (size_t)b * 2048 + 1024, F.lane, h);
        row_store_bf16(hB + (size_t)(T + m) * D, F.lane, h);
    }
    LAS float* scr = (LAS float*)(F.lds + F.wave * 16384);
    conv_moe_layer(F, a, 1, (bf16_t*)(a->ws + WS_GU), (bf16_t*)(a->ws + WS_DN), scr);
}

__device__ __forceinline__ void phase_final(const Frame& F, ArgsP a) {
    const int gw = blockIdx.x * NWAVES + F.wave, NGW = F.G * NWAVES;
    const float* mod1 = (const float*)(a->ws + WS_MOD) + MOD_L;
    float* X = a->out; const bf16_t* Y = (const bf16_t*)(a->ws + WS_SCR);
    for (int m = gw; m < T; m += NGW) {
        const int b = m / SEQ; float v[16], g[16];
        row_load(X + (size_t)m * D, F.lane, v);
        row_add_y(v, Y + (size_t)m * TOPK * D, mod1 + (size_t)b * 6144 + 5120, F.lane);
        const float rstd = row_rstd(v);
        row_load(a->in[28], F.lane, g);
#pragma unroll
        for (int j = 0; j < 16; ++j) v[j] = v[j] * rstd * g[j];
        row_store(X + (size_t)m * D, F.lane, v);
    }
}
#ifndef MK_N_LAUNCHES
#define MK_N_LAUNCHES 1
#endif
constexpr int N_PHASES = 16;
#ifndef REF_MASK
#define REF_MASK 0u
#endif
#define GEMM_RUN(k, GATHER, A, B, K, S, E) do { if ((REF_MASK >> (k)) & 1u) gemm_ref(A, B, K, S, E); else pg8::gemm_phase<GATHER>(F.lds, A, B, K, S, E); } while (0)
constexpr int N_LAUNCHES = MK_N_LAUNCHES;

__global__ void __launch_bounds__(NTHREADS, 2) yoco_fwd(Args args) {
    extern __shared__ __attribute__((aligned(16))) unsigned char lds[];
    Frame F;
    F.lds = (LAS unsigned char*)lds;
    F.MISC = (volatile LAS unsigned*)(F.lds + MISC_OFF);
    F.tid = threadIdx.x; F.lane = F.tid & 63; F.wave = __builtin_amdgcn_readfirstlane(F.tid >> 6);
    F.G = gridDim.x; { const int bx = blockIdx.x; F.vcu = (F.G % 8 == 0) ? (bx % 8) * (F.G / 8) + bx / 8 : bx; }
    F.ctl = (gu32*)(args.ws + WS_CTL);
    for (int u = F.tid; u < (LDS_BYTES - LDSCTL_OFF) / 4; u += NTHREADS) ((LAS unsigned*)(F.lds + LDSCTL_OFF))[u] = 0u;
    __syncthreads();
    XcdBarrier bar; bar.bar = (unsigned*)(F.ctl + CW_BAR); bar.x = 0; bar.st = nullptr;
    if (N_LAUNCHES == 1) bar = xcd_barrier_post((unsigned*)(F.ctl + CW_BAR), F.MISC + 8);
#define GRID_BAR() do { if (N_LAUNCHES == 1) xcd_barrier(bar); } while (0)
    const int lo = args.ph_lo, hi = args.ph_hi;
#ifndef PH_MASK
#define PH_MASK 0xFFFFFFFFu
#endif
#define PHON(k) ((PH_MASK >> (k)) & 1u)
#define IN(k) (lo <= (k) && (k) < hi && PHON((k) >= 12 ? (k) - 7 : (k)))
#ifdef PROBE_MASK
#define PRB(k) ((PROBE_MASK >> (k)) & 1u)
    volatile LAS unsigned long long* prb = (volatile LAS unsigned long long*)(F.lds + MISC_OFF + 64);
    if (F.tid == 0) prb[0] = __builtin_amdgcn_s_memrealtime();
#define SEAM(k) do { if (IN(k) && IN((k) + 1)) GRID_BAR(); if (F.tid == 0) { if (PRB(k)) prb[1] = prb[1] + (__builtin_amdgcn_s_memrealtime() - prb[0]); if (PRB((k) + 1)) prb[0] = __builtin_amdgcn_s_memrealtime(); } } while (0)
#else
#define SEAM(k) do { if (IN(k) && IN((k) + 1)) GRID_BAR(); } while (0)
#endif
    LAS int* cntl = (LAS int*)(F.lds + LDS_AUX + 8192); LAS int* tb = cntl + 64;
    const int c = (int)blockIdx.x;

    if (IN(0)) { phase_p0(F, fresh_args()); } SEAM(0);
    if (IN(1)) { phase_p1(F, fresh_args()); } SEAM(1);
    if (IN(2)) {
        ArgsP a = fresh_args(); unsigned char* ws = a->ws;
        DenseSched S; S.init(T, 4096, F.G, c);
        EpiGemm1 E{(bf16_t*)(ws + WS_SCR + 64 * MiB), (bf16_t*)(ws + WS_SCR + 128 * MiB), (float*)(ws + WS_VPART), a->in[7]};
        GEMM_RUN(2, false, (const bf16_t*)(ws + WS_SCR), (const bf16_t*)(ws + WS_WIN_T), 1024, S, E);
    } SEAM(2);
    if (IN(3)) { phase_p3(F, fresh_args()); } SEAM(3);
    if (IN(4)) {
        ArgsP a = fresh_args(); unsigned char* ws = a->ws;
        DenseSched S; S.init(T, 1024, F.G, c);
        EpiResid E{a->in[0], a->out, (const float*)(ws + WS_MOD) + 2048, 6144};
        GEMM_RUN(4, false, (const bf16_t*)(ws + WS_SCR + 64 * MiB), (const bf16_t*)(ws + WS_WOUT_T), 2048, S, E);
    } SEAM(4);
#define MOE_PHASES(layer, pb) \
    if (IN(pb)) { phase_router(F, fresh_args(), layer); } SEAM(pb); \
    if (IN(pb + 1)) { ArgsP a = fresh_args(); unsigned char* ws = a->ws; \
        moe_tables(F, a, layer, cntl, tb); \
        MoeSched<true> S; S.init(tb, cntl, (const int*)(ws + WS_TOKLIST), F.G, F.vcu); \
        EpiGateUp E{(bf16_t*)(ws + WS_H)}; \
        GEMM_RUN(6, true, (const bf16_t*)(ws + WS_SCR), (const bf16_t*)(ws + WS_GU), 1024, S, E); \
    } SEAM(pb + 1); \
    if (IN(pb + 2)) { ArgsP a = fresh_args(); unsigned char* ws = a->ws; \
        moe_tables(F, a, layer, cntl, tb); \
        MoeSched<false> S; S.init(tb, cntl, (const int*)(ws + WS_TOKLIST), F.G, F.vcu); \
        EpiDown E{(bf16_t*)(ws + WS_SCR), a->out, (const int*)(ws + WS_TOKLIST), (const float*)(ws + WS_WLIST), (const float*)(ws + WS_MOD) + (size_t)layer * MOD_L + 5120, 6144, tb}; \
        GEMM_RUN(7, false, (const bf16_t*)(ws + WS_H), (const bf16_t*)(ws + WS_DN), 256, S, E); \
    } SEAM(pb + 2);
    MOE_PHASES(0, 5)
    if (IN(8)) { phase_p8(F, fresh_args()); } SEAM(8);
    if (IN(9)) {
        ArgsP a = fresh_args(); unsigned char* ws = a->ws;
        DenseSched S; S.init(T, 3072, F.G, c, 4, T);
        EpiQKV E{(bf16_t*)(ws + WS_SCR + 64 * MiB), (float*)(ws + WS_CTL + CTL_KMEAN)};
        GEMM_RUN(9, false, (const bf16_t*)(ws + WS_H), (const bf16_t*)(ws + WS_WQKV_T), 1024, S, E);
    } SEAM(9);
    if (IN(10)) {
        ArgsP a = fresh_args(); unsigned char* ws = a->ws;
        const attn_body::AttnTensors AT{(const attn_body::bf16*)(ws + WS_SCR + 64 * MiB), (const attn_body::bf16*)(ws + WS_SCR + 96 * MiB), (const attn_body::bf16*)(ws + WS_SCR + 128 * MiB),
                                        (attn_body::bf16*)(ws + WS_SCR + 64 * MiB), (const float*)(ws + WS_CTL + CTL_KMEAN)};
        const attn_body::StaticOrder S((int)F.G, (int)blockIdx.x);
        attn_body::attn_phase<attn_body::StaticOrder>((char*)lds, AT, S);
    } SEAM(10);
    if (IN(11)) {
        ArgsP a = fresh_args(); unsigned char* ws = a->ws;
        DenseSched S; S.init(T, 1024, F.G, c);
        EpiResid E{a->out, a->out, (const float*)(ws + WS_MOD) + MOD_L + 2048, 6144};
        GEMM_RUN(11, false, (const bf16_t*)(ws + WS_SCR + 64 * MiB), (const bf16_t*)(ws + WS_WO_T), 1024, S, E);
    } SEAM(11);
    MOE_PHASES(1, 12)
    if (IN(15)) { phase_final(F, fresh_args()); }
#ifdef PROBE_MASK
    if (blockIdx.x == 0 && F.tid == 0) { if (PRB(15)) prb[1] = prb[1] + (__builtin_amdgcn_s_memrealtime() - prb[0]); const unsigned long long pdur = prb[1], te = __builtin_amdgcn_s_memrealtime(); while (__builtin_amdgcn_s_memrealtime() - te < pdur) __builtin_amdgcn_s_sleep(8); }
#endif
#undef IN
#undef SEAM
#undef GRID_BAR
}

extern "C" void kernel_launch(void* const* d_in, const int* in_sizes, int n_in, void* d_out, int out_size, void* d_ws, size_t ws_size, hipStream_t stream) {
    static int grid = 0;
    if (grid == 0) {
        if (n_in != 29 || in_sizes[0] != T * D || out_size != T * D || ws_size < WS_END) {
            fprintf(stderr, "kernel_launch: shape/workspace mismatch: n_in %d in0 %d out %d ws %zu (need %zu); nothing launched\n", n_in, n_in > 0 ? in_sizes[0] : -1, out_size, ws_size, (size_t)WS_END); grid = -1; return; }
        int dev = 0, cus = 0, per_cu = 0;
        if (hipGetDevice(&dev) != hipSuccess || hipDeviceGetAttribute(&cus, hipDeviceAttributeMultiprocessorCount, dev) != hipSuccess) { grid = -1; return; }
        if (hipFuncSetAttribute((const void*)yoco_fwd, hipFuncAttributeMaxDynamicSharedMemorySize, LDS_BYTES) != hipSuccess) { fprintf(stderr, "kernel_launch: hipFuncSetAttribute failed\n"); grid = -1; return; }
        if (hipOccupancyMaxActiveBlocksPerMultiprocessor(&per_cu, (const void*)yoco_fwd, NTHREADS, LDS_BYTES) != hipSuccess || per_cu < 1)
            fprintf(stderr, "kernel_launch: note: occupancy query reports %d workgroups per CU\n", per_cu);
        (void)hipGetLastError();
        grid = cus;
    }
    if (grid < 0) return;
    if (hipMemsetAsync((char*)d_ws + WS_CTL, 0, CTL_ZERO_BYTES, stream) != hipSuccess) return;
    Args a{};
    for (int i = 0; i < 29; ++i) a.in[i] = (const float*)d_in[i];
    a.out = (float*)d_out; a.ws = (unsigned char*)d_ws;
    for (int li = 0; li < N_LAUNCHES; ++li) {
        a.ph_lo = (N_LAUNCHES == 1) ? 0 : li; a.ph_hi = (N_LAUNCHES == 1) ? N_PHASES : li + 1; a.li = li;
        hipLaunchKernelGGL(yoco_fwd, dim3(grid), dim3(NTHREADS), LDS_BYTES, stream, a);
    }
}
```
